# Optimizing an MI355X kernel written in HIP

```python
import jax, jax.numpy as jnp
from jax import lax
import numpy as np

D_MODEL = 1024
BATCH = 16
SEQ = 256
DEPTH = 4
DEC_BATCH = 4
DEC_SEQ = 2048
PAST_LEN = 256

GRID_W = 64
EXPAND = 2
MIX_WIDTH = EXPAND * D_MODEL
BRANCH_W = MIX_WIDTH // 2
HEAD_DK = 128
HEAD_DV = 128
N_HEADS_A = BRANCH_W // HEAD_DV
CHUNK_A = 32
POOL_WINDOWS = (2, 4, 8, 16)
N_POOL_GROUPS = len(POOL_WINDOWS)
POOL_GROUP_W = BRANCH_W // N_POOL_GROUPS
CHUNK_C = 128
N_GROUPS_C = 8
GROUP_W_C = MIX_WIDTH // N_GROUPS_C
N_AB_LAYERS = (DEPTH + 1) // 2
N_C_LAYERS = DEPTH // 2
AB_IN = 7 * BRANCH_W
C_IN = 3 * MIX_WIDTH
EPS = 1e-6

kernel_name = "hybrid_hgrn2_pool_gmlp_diffusion_step"


def _rmsnorm(x, g):
    xf = x.astype(jnp.float32)
    y = xf * lax.rsqrt(jnp.mean(xf * xf, axis=-1, keepdims=True) + EPS)
    return (y * g.astype(jnp.float32)).astype(x.dtype)


def _modulation(cond, w_ada, b_ada):
    m = jax.nn.silu(cond) @ w_ada + b_ada
    shift, scale, gate = jnp.split(m, 3, axis=-1)
    return shift[:, None, :], scale[:, None, :], gate[:, None, :]


def _hgrn_chunk_scan(q, k, v, log_f, s0):
    b, h, t, dk = q.shape
    n = t // CHUNK_A

    def to_chunks(a):
        return a.reshape(b, h, n, CHUNK_A, a.shape[-1]).transpose(2, 0, 1, 3, 4)

    mask = jnp.tril(jnp.ones((CHUNK_A, CHUNK_A), dtype=bool))[:, :, None]

    def step(s, inp):
        qi, ki, vi, gi = inp
        bcum = jnp.cumsum(gi, axis=2)
        diff = bcum[:, :, :, None, :] - bcum[:, :, None, :, :]
        decay = jnp.exp(jnp.where(mask, diff, -jnp.inf))
        scores = jnp.einsum('bhtd,bhsd,bhtsd->bhts', qi, ki, decay)
        o = jnp.einsum('bhts,bhse->bhte', scores, vi) + jnp.einsum('bhtd,bhde->bhte', qi * jnp.exp(bcum), s)
        b_last = bcum[:, :, -1:, :]
        s_new = jnp.exp(b_last[:, :, 0, :])[..., None] * s + jnp.einsum('bhsd,bhse->bhde', ki * jnp.exp(b_last - bcum), vi)
        return s_new, o

    s_fin, oc = lax.scan(step, s0, (to_chunks(q), to_chunks(k), to_chunks(v), to_chunks(log_f)))
    o = oc.transpose(1, 2, 0, 3, 4).reshape(b, h, t, v.shape[-1])
    return o, s_fin


def _hgrn_bidir(q, i_in, f_pre_fwd, f_pre_bwd, lb, s0):
    bsz, t, _ = q.shape

    def heads(a, d):
        return a.reshape(bsz, t, N_HEADS_A, d).transpose(0, 2, 1, 3).astype(jnp.float32)

    qh = heads(jax.nn.silu(q), HEAD_DK)
    vh = heads(i_in, HEAD_DV)
    o_sum = None
    finals = []
    for d, f_pre in enumerate((f_pre_fwd, f_pre_bwd)):
        lbd = lb[d].astype(jnp.float32).reshape(1, N_HEADS_A, 1, HEAD_DK)
        f = lbd + (1.0 - lbd) * jax.nn.sigmoid(heads(f_pre, HEAD_DK))
        log_f = jnp.log(f)
        k = 1.0 - f
        qd, kd, vd, gd = qh, k, vh, log_f
        if d == 1:
            qd, kd, vd, gd = qd[:, :, ::-1], kd[:, :, ::-1], vd[:, :, ::-1], gd[:, :, ::-1]
        o, s_fin = _hgrn_chunk_scan(qd, kd, vd, gd, s0[:, d].astype(jnp.float32))
        if d == 1:
            o = o[:, :, ::-1]
        o_sum = o if o_sum is None else o_sum + o
        finals.append(s_fin)
    return o_sum, jnp.stack(finals, axis=1)


def _centred_mean(x, w, axis):
    n = x.shape[axis]
    xf = x.astype(jnp.float32)
    cs = jnp.cumsum(xf, axis=axis)
    zshape = list(xf.shape)
    zshape[axis] = 1
    cs = jnp.concatenate([jnp.zeros(zshape, jnp.float32), cs], axis=axis)
    pos = jnp.arange(n)
    lo = jnp.clip(pos - w // 2, 0, n)
    hi = jnp.clip(pos - w // 2 + w, 0, n)
    s = jnp.take(cs, hi, axis=axis) - jnp.take(cs, lo, axis=axis)
    cshape = [1] * xf.ndim
    cshape[axis] = n
    cnt = (hi - lo).astype(jnp.float32).reshape(cshape)
    return s / cnt


def _pool_mixer(p, w_pool, pool_scale, grid):
    b, t, _ = p.shape
    groups = p.reshape(b, t, N_POOL_GROUPS, POOL_GROUP_W)
    outs = []
    for gi, w in enumerate(POOL_WINDOWS):
        xg = groups[:, :, gi]
        if grid:
            rows = t // GRID_W
            xs = xg.reshape(b, rows, GRID_W, POOL_GROUP_W)
            m = _centred_mean(_centred_mean(xs, w, 1), w, 2).reshape(b, t, POOL_GROUP_W)
        else:
            m = _centred_mean(xg, w, 1)
        outs.append(m - xg.astype(jnp.float32))
    dlt = jnp.stack(outs, axis=2).astype(p.dtype)
    y = jnp.einsum('btgc,gce->btge', dlt, w_pool).reshape(b, t, BRANCH_W)
    return y * pool_scale


def _chunk_mlp(u, v, ln_g, ln_b, w_s, b_s):
    b, t, _ = v.shape
    vf = v.astype(jnp.float32)
    mu = jnp.mean(vf, axis=-1, keepdims=True)
    var = jnp.mean(jnp.square(vf - mu), axis=-1, keepdims=True)
    vn = ((vf - mu) * lax.rsqrt(var + EPS) * ln_g.astype(jnp.float32) + ln_b.astype(jnp.float32)).astype(v.dtype)
    vc = vn.reshape(b, t // CHUNK_C, CHUNK_C, N_GROUPS_C, GROUP_W_C)
    sp = jnp.einsum('gts,bnsgc->bntgc', w_s, vc) + b_s.T[None, None, :, :, None]
    return u * sp.reshape(b, t, MIX_WIDTH)


def _layer_ab(x, shift, scale, gate, g_pre, g_post, w_in, w_out, lb, g_onorm, w_pool, pool_scale, s0, grid):
    h = _rmsnorm(x, g_pre) * (1.0 + scale) + shift
    proj = h @ w_in
    q, f_f, f_b, i_in, gate_a, p, gate_b = jnp.split(proj, 7, axis=-1)
    o, s_fin = _hgrn_bidir(q, i_in, f_f, f_b, lb, s0)
    b, _, t, _ = o.shape
    o = _rmsnorm(o, g_onorm).transpose(0, 2, 1, 3).reshape(b, t, BRANCH_W).astype(x.dtype)
    y_a = o * jax.nn.silu(gate_a)
    y_b = _pool_mixer(p, w_pool, pool_scale, grid) * jax.nn.silu(gate_b)
    y = jnp.concatenate([y_a, y_b], axis=-1) @ w_out
    return x + gate * _rmsnorm(y, g_post), s_fin


def _layer_c(x, shift, scale, gate, g_pre, g_post, w_in, w_out, ln_g, ln_b, w_s, b_s):
    h = _rmsnorm(x, g_pre) * (1.0 + scale) + shift
    u, v, g = jnp.split(h @ w_in, 3, axis=-1)
    y = (_chunk_mlp(u, v, ln_g, ln_b, w_s, b_s) * jax.nn.silu(g)) @ w_out
    return x + gate * _rmsnorm(y, g_post)


def setup_inputs(seed: int = 0) -> dict:
    key = jax.random.key(seed)
    ks = jax.random.split(key, 24)
    f32 = jnp.float32
    nrm = lambda k, s: jax.random.normal(k, s, f32)
    return {
        "x_prompt": nrm(ks[0], (BATCH, SEQ, D_MODEL)),
        "x_sample": nrm(ks[1], (DEC_BATCH, DEC_SEQ, D_MODEL)),
        "c": nrm(ks[2], (DEC_BATCH, D_MODEL)),
        "state_hgrn": 0.5 * nrm(ks[3], (DEC_BATCH, N_AB_LAYERS, 2, N_HEADS_A, HEAD_DK, HEAD_DV)),
        "c_ctx": nrm(ks[4], (D_MODEL,)),
        "w_ada": 0.5 * D_MODEL ** -0.5 * nrm(ks[5], (DEPTH, D_MODEL, 3 * D_MODEL)),
        "b_ada": 0.01 * nrm(ks[6], (DEPTH, 3 * D_MODEL)),
        "g_pre": 1.0 + 0.02 * nrm(ks[7], (DEPTH, D_MODEL)),
        "g_post": 1.0 + 0.02 * nrm(ks[8], (DEPTH, D_MODEL)),
        "w_in_ab": D_MODEL ** -0.5 * nrm(ks[9], (N_AB_LAYERS, D_MODEL, AB_IN)),
        "w_out_ab": MIX_WIDTH ** -0.5 * nrm(ks[10], (N_AB_LAYERS, MIX_WIDTH, D_MODEL)),
        "lb_logits": 0.5 * nrm(ks[11], (N_AB_LAYERS, 2, N_HEADS_A * HEAD_DK)),
        "g_onorm_a": 1.0 + 0.02 * nrm(ks[12], (N_AB_LAYERS, HEAD_DV)),
        "w_pool": POOL_GROUP_W ** -0.5 * nrm(ks[13], (N_AB_LAYERS, N_POOL_GROUPS, POOL_GROUP_W, POOL_GROUP_W)),
        "pool_scale": 1.0 + 0.02 * nrm(ks[14], (N_AB_LAYERS, BRANCH_W)),
        "w_in_c": D_MODEL ** -0.5 * nrm(ks[15], (N_C_LAYERS, D_MODEL, C_IN)),
        "w_out_c": MIX_WIDTH ** -0.5 * nrm(ks[16], (N_C_LAYERS, MIX_WIDTH, D_MODEL)),
        "ln_v_g": 1.0 + 0.02 * nrm(ks[17], (N_C_LAYERS, MIX_WIDTH)),
        "ln_v_b": 0.02 * nrm(ks[18], (N_C_LAYERS, MIX_WIDTH)),
        "w_spatial": CHUNK_C ** -0.5 * nrm(ks[19], (N_C_LAYERS, N_GROUPS_C, CHUNK_C, CHUNK_C)),
        "b_spatial": 1.0 + 0.02 * nrm(ks[20], (N_C_LAYERS, N_GROUPS_C, CHUNK_C)),
    }


def reference(x_prompt, x_sample, c, state_hgrn, c_ctx, w_ada, b_ada, g_pre, g_post, w_in_ab, w_out_ab, lb_logits, g_onorm_a, w_pool, pool_scale, w_in_c, w_out_c, ln_v_g, ln_v_b, w_spatial, b_spatial):
    lbf = jax.nn.softmax(lb_logits.astype(jnp.float32), axis=0)
    lb_all = jnp.cumsum(lbf, axis=0) - lbf[0:1]
    zero_state = jnp.zeros((x_prompt.shape[0], 2, N_HEADS_A, HEAD_DK, HEAD_DV), jnp.float32)
    y_p, y_s = x_prompt, x_sample
    ctx_states = []
    for l in range(DEPTH):
        m_ctx = _modulation(c_ctx[None, :], w_ada[l], b_ada[l])
        m_lat = _modulation(c, w_ada[l], b_ada[l])
        j = l // 2
        if l % 2 == 0:
            y_p, s_ctx = _layer_ab(y_p, *m_ctx, g_pre[l], g_post[l], w_in_ab[j], w_out_ab[j], lb_all[j], g_onorm_a[j], w_pool[j], pool_scale[j], zero_state, False)
            y_s, _ = _layer_ab(y_s, *m_lat, g_pre[l], g_post[l], w_in_ab[j], w_out_ab[j], lb_all[j], g_onorm_a[j], w_pool[j], pool_scale[j], state_hgrn[:, j], True)
            ctx_states.append(s_ctx)
        else:
            y_p = _layer_c(y_p, *m_ctx, g_pre[l], g_post[l], w_in_c[j], w_out_c[j], ln_v_g[j], ln_v_b[j], w_spatial[j], b_spatial[j])
            y_s = _layer_c(y_s, *m_lat, g_pre[l], g_post[l], w_in_c[j], w_out_c[j], ln_v_g[j], ln_v_b[j], w_spatial[j], b_spatial[j])
    new_state_hgrn = jnp.stack(ctx_states, axis=1)
    return (y_p, y_s, new_state_hgrn)
```

```cpp
#include <hip/hip_runtime.h>
#include <hip/hip_cooperative_groups.h>
#include <cstdio>
namespace cg = cooperative_groups;
namespace pg8 {
#define PG8_LAS __attribute__((address_space(3)))
typedef unsigned short bf16_t;
typedef short bf16x8 __attribute__((ext_vector_type(8)));
typedef float f32x4 __attribute__((ext_vector_type(4)));
typedef unsigned u32x4 __attribute__((ext_vector_type(4)));
constexpr int BM = 256, BK = 64, HALF = 128, HTB = HALF * BK * 2  , STAGE_BYTES = 8 * HTB, NXCD = 8, WGM = 8;

__host__ __device__ __forceinline__ int lds_byte(int r, int c) { const int st = (r >> 4) * 2 + (c >> 5), rr = r & 15, cc = c & 31, ob = rr * 64 + cc * 2; return st * 1024 + (ob ^ (((ob >> 9) & 1) << 5)); }
__host__ __device__ __forceinline__ void stage_rc(int b, int& R, int& C) { const int st = b / 1024, sb = b % 1024, swz = sb ^ (((sb >> 9) & 1) << 5); R = (st >> 1) * 16 + swz / 64; C = (st & 1) * 32 + (swz % 64) / 2; }
__host__ __device__ __forceinline__ int perm32(int rho) { const int n = rho >> 4, i = rho & 15; return 8 * (i >> 2) + 4 * n + (i & 3); }

struct Unit { int pm, pn; };
struct Gemm { const bf16_t* A; const bf16_t* Bt; int M, N, K; };

struct StaticOrder {
    int nM, nN, nwg, G, c;
    __host__ __device__ void init(int M, int N, int G_, int c_) { nM = M / BM; nN = N / BM; nwg = nM * nN; G = G_; c = c_; }
    __host__ __device__ bool next(int i, Unit& u) const {
        const long L = (long)i * G + c; if (L >= nwg) return false;
        int wgid = (int)L; { const int q = nwg / NXCD, r = nwg % NXCD, xcd = wgid % NXCD, off = wgid / NXCD; wgid = (xcd < r ? xcd * (q + 1) : r * (q + 1) + (xcd - r) * q) + off; }
        const int nig = WGM * nN, gid = wgid / nig, fm = gid * WGM, gsz = (nM - fm) < WGM ? (nM - fm) : WGM;
        u.pm = fm + ((wgid % nig) % gsz); u.pn = (wgid % nig) / gsz; return true;
    }
    __device__ __forceinline__ void a_ready(const Unit&) const {}
    __device__ __forceinline__ void done(const Unit&) const {}
};
__device__ __forceinline__ unsigned cvt_pk_bf16(float lo, float hi) { unsigned r; asm volatile("v_cvt_pk_bf16_f32 %0, %1, %2\n\ts_nop 1" : "=v"(r) : "v"(lo), "v"(hi)); return r; }
typedef float f32x2 __attribute__((ext_vector_type(2)));
struct EpiF32 {
    static constexpr bool PERM = false, AFTER_DRAIN = false;
    float* C; int ldc;
    __device__ __forceinline__ void operator()(const f32x4 (&acc)[2][2][4][2], const Unit& u, int wr, int wc, int fr, int fq) const {
        const int row0 = u.pm * BM + wr * 64 + fr, col0 = u.pn * BM + wc * 32 + 4 * fq;
#pragma unroll
        for (int ai = 0; ai < 2; ++ai)
#pragma unroll
            for (int m = 0; m < 4; ++m) { float* rowp = C + (size_t)(row0 + ai * HALF + m * 16) * ldc + col0;
#pragma unroll
                for (int bj = 0; bj < 2; ++bj)
#pragma unroll
                    for (int n = 0; n < 2; ++n) *(f32x4*)(rowp + bj * HALF + n * 16) = acc[ai][bj][m][n]; }
    }
};
struct EpiBf16S {
    static constexpr bool PERM = true, AFTER_DRAIN = false;
    bf16_t* O; int ldc; float* stats; int st_lo, st_hi;
    __device__ __forceinline__ void operator()(const f32x4 (&acc)[2][2][4][2], const Unit& u, int wr, int wc, int fr, int fq) const {
        const int row0 = u.pm * BM + wr * 64 + fr; const int col0 = u.pn * BM + wc * 32 + 8 * fq;
        const bool dost = (stats != nullptr) && u.pn >= st_lo && u.pn < st_hi;
#pragma unroll
        for (int ai = 0; ai < 2; ++ai)
#pragma unroll
            for (int m = 0; m < 4; ++m) { const int row = row0 + ai * HALF + m * 16; bf16_t* rowp = O + (size_t)row * ldc + col0; float s = 0.f, q = 0.f;
#pragma unroll
                for (int bj = 0; bj < 2; ++bj) { const f32x4 v0 = acc[ai][bj][m][0], v1 = acc[ai][bj][m][1];
                    u32x4 w; w.x = cvt_pk_bf16(v0[0], v0[1]); w.y = cvt_pk_bf16(v0[2], v0[3]); w.z = cvt_pk_bf16(v1[0], v1[1]); w.w = cvt_pk_bf16(v1[2], v1[3]);
                    *(u32x4*)(rowp + bj * HALF) = w;
                    s += (v0[0] + v0[1]) + (v0[2] + v0[3]) + (v1[0] + v1[1]) + (v1[2] + v1[3]);
                    q += (v0[0] * v0[0] + v0[1] * v0[1]) + (v0[2] * v0[2] + v0[3] * v0[3]) + (v1[0] * v1[0] + v1[1] * v1[1]) + (v1[2] * v1[2] + v1[3] * v1[3]); }
                if (dost) { s += __shfl_xor(s, 16); s += __shfl_xor(s, 32); q += __shfl_xor(q, 16); q += __shfl_xor(q, 32);
                    if (fq == 0) { float* sp = stats + (((size_t)(u.pn - st_lo) * 12288 + row) * 4 + wc) * 2; sp[0] = s; sp[1] = q; } } }
    }
};
template <class Epi, class Sched, bool STAMP = false>
__device__ __forceinline__ void gemm_phase(PG8_LAS unsigned char* lds, const Gemm g, const Sched& S, const Epi& E, unsigned long long* stamps) {
    int tid_l = threadIdx.x; asm volatile("" : "+v"(tid_l));
    const int tid = tid_l, wid = __builtin_amdgcn_readfirstlane(tid >> 6), lane = tid & 63, wr = wid >> 2, wc = wid & 3, fr = lane & 15, fq = lane >> 4;
    const int K = g.K, nt = K / BK;
    int ts_lo = 0, ts_hi = 0, nts = 0; const unsigned long long rt_entry = STAMP ? (unsigned long long)wall_clock64() : 0ull;
#define PG8_STAMP() do { if (STAMP && wid == 0 && nts < 64) { const unsigned long long _c = (unsigned long long)clock64(); \
        ts_lo = (lane == nts) ? (int)(unsigned)_c : ts_lo; ts_hi = (lane == nts) ? (int)(unsigned)(_c >> 32) : ts_hi; ++nts; } } while (0)
    PG8_STAMP();
    unsigned voffA[2], voffB[2];
#pragma unroll
    for (int i = 0; i < 2; ++i) { int R, C; stage_rc(tid * 16 + i * 8192, R, C); const int Rb = Epi::PERM ? ((R & ~31) + perm32(R & 31)) : R;
        voffA[i] = (unsigned)(R * K + C) * 2u; voffB[i] = (unsigned)(Rb * K + C) * 2u; }
    const size_t kstep = (size_t)(BK * 2);
    const size_t hstep = (size_t)HALF * K * 2;
    const size_t tstep = 2 * hstep;
    const unsigned ldsw = (unsigned)wid * 1024u;
    const int aoff = lds_byte(wr * 64 + fr, fq * 8), boff = lds_byte(wc * 32 + fr, fq * 8);
#define PG8_SA(b, h) (((b) * 2 + (h)) * HTB)
#define PG8_SB(b, h) ((4 + (b) * 2 + (h)) * HTB)
#define PG8_STAGE(bufoff, gbase, voff) do { _Pragma("unroll") for (int _i = 0; _i < 2; ++_i) \
        __builtin_amdgcn_global_load_lds((const unsigned*)((const char*)(gbase) + (voff)[_i]), (PG8_LAS unsigned*)(lds + (bufoff) + ldsw + _i * 8192), 16, 0, 0); } while (0)
#define PG8_LDA(dst, b, h) do { _Pragma("unroll") for (int m = 0; m < 4; ++m) _Pragma("unroll") for (int k = 0; k < 2; ++k) dst[m][k] = *(const PG8_LAS bf16x8*)(lds + PG8_SA(b, h) + aoff + m * 2048 + k * 1024); } while (0)
#define PG8_LDB(dst, b, h) do { _Pragma("unroll") for (int n = 0; n < 2; ++n) _Pragma("unroll") for (int k = 0; k < 2; ++k) dst[n][k] = *(const PG8_LAS bf16x8*)(lds + PG8_SB(b, h) + boff + n * 2048 + k * 1024); } while (0)
#define PG8_MMA(ai, bj, At, Bt) do { __builtin_amdgcn_s_setprio(1); _Pragma("unroll") for (int m = 0; m < 4; ++m) _Pragma("unroll") for (int n = 0; n < 2; ++n) _Pragma("unroll") for (int k = 0; k < 2; ++k) \
        acc[ai][bj][m][n] = __builtin_amdgcn_mfma_f32_16x16x32_bf16(Bt[n][k], At[m][k], acc[ai][bj][m][n], 0, 0, 0); __builtin_amdgcn_s_setprio(0); } while (0)
#define PG8_WAIT_V(n) asm volatile("s_waitcnt vmcnt(" #n ")" ::: "memory")
#define PG8_WAIT_L(n) asm volatile("s_waitcnt lgkmcnt(" #n ")" ::: "memory")
#define PG8_BAR __builtin_amdgcn_s_barrier()
#define PG8_SCHED __builtin_amdgcn_sched_barrier(0)
    Unit cur, nxt; int ui = 0;
    if (!S.next(0, cur)) return;
    f32x4 acc[2][2][4][2];
#pragma unroll
    for (int a = 0; a < 2; ++a)
#pragma unroll
        for (int b = 0; b < 2; ++b)
#pragma unroll
            for (int m = 0; m < 4; ++m)
#pragma unroll
                for (int n = 0; n < 2; ++n) acc[a][b][m][n] = (f32x4){0.f, 0.f, 0.f, 0.f};
    bf16x8 At[4][2], B0[2][2], B1[2][2];
    const char* cA = (const char*)g.A + (size_t)cur.pm * tstep; const char* cB = (const char*)g.Bt + (size_t)cur.pn * tstep;
    S.a_ready(cur);
    PG8_STAGE(PG8_SB(0, 0), cB, voffB); PG8_STAGE(PG8_SA(0, 0), cA, voffA); PG8_STAGE(PG8_SB(0, 1), cB + hstep, voffB); PG8_STAGE(PG8_SA(0, 1), cA + hstep, voffA);
    if (wr == 1) PG8_BAR;
    PG8_WAIT_V(4); PG8_BAR;
    PG8_STAGE(PG8_SB(1, 0), cB + kstep, voffB); PG8_STAGE(PG8_SA(1, 0), cA + kstep, voffA); PG8_STAGE(PG8_SB(1, 1), cB + hstep + kstep, voffB);
    PG8_WAIT_V(6); PG8_BAR;
    PG8_STAMP();
    for (;;) {
        const bool has_next = S.next(ui + 1, nxt);
        const char* nA = has_next ? (const char*)g.A + (size_t)nxt.pm * tstep : cA; const char* nB = has_next ? (const char*)g.Bt + (size_t)nxt.pn * tstep : cB;
        for (int t = 0; t < nt; t += 2) {
            const bool last = (t == nt - 2);
            const char* a1 = cA + (size_t)(t + 1) * kstep;
            const char* a2 = last ? nA : cA + (size_t)(t + 2) * kstep; const char* b2 = last ? nB : cB + (size_t)(t + 2) * kstep;
            const char* a3 = a2 + kstep; const char* b3 = b2 + kstep;
            if (last && has_next) S.a_ready(nxt);
            PG8_LDB(B0, 0, 0); PG8_SCHED; PG8_LDA(At, 0, 0); PG8_STAGE(PG8_SA(1, 1), a1 + hstep, voffA);
            PG8_WAIT_L(8); PG8_BAR; PG8_WAIT_L(0); PG8_MMA(0, 0, At, B0); PG8_BAR; PG8_SCHED;
            PG8_LDB(B1, 0, 1); PG8_STAGE(PG8_SB(0, 0), b2, voffB);
            PG8_BAR; PG8_WAIT_L(0); PG8_MMA(0, 1, At, B1); PG8_BAR;
            PG8_LDA(At, 0, 1); PG8_STAGE(PG8_SA(0, 0), a2, voffA);
            PG8_BAR; PG8_WAIT_L(0); PG8_MMA(1, 0, At, B0); PG8_BAR; PG8_SCHED;
            PG8_STAGE(PG8_SB(0, 1), b2 + hstep, voffB);
            PG8_WAIT_V(6); PG8_BAR; PG8_MMA(1, 1, At, B1); PG8_BAR;
            PG8_LDB(B0, 1, 0); PG8_SCHED; PG8_LDA(At, 1, 0); PG8_STAGE(PG8_SA(0, 1), a2 + hstep, voffA);
            PG8_WAIT_L(8); PG8_BAR; PG8_WAIT_L(0); PG8_MMA(0, 0, At, B0); PG8_BAR; PG8_SCHED;
            PG8_LDB(B1, 1, 1); PG8_STAGE(PG8_SB(1, 0), b3, voffB);
            PG8_BAR; PG8_WAIT_L(0); PG8_MMA(0, 1, At, B1); PG8_BAR;
            PG8_LDA(At, 1, 1); PG8_STAGE(PG8_SA(1, 0), a3, voffA);
            PG8_BAR; PG8_WAIT_L(0); PG8_MMA(1, 0, At, B0); PG8_BAR; PG8_SCHED;
            PG8_STAGE(PG8_SB(1, 1), b3 + hstep, voffB);
            PG8_WAIT_V(6); PG8_BAR; PG8_MMA(1, 1, At, B1); PG8_BAR;
        }
        PG8_STAMP();
        if constexpr (!Epi::AFTER_DRAIN) { E(acc, cur, wr, wc, fr, fq); S.done(cur); }
        PG8_STAMP();
        if (!has_next) break;
#pragma unroll
        for (int a = 0; a < 2; ++a)
#pragma unroll
            for (int b = 0; b < 2; ++b)
#pragma unroll
                for (int m = 0; m < 4; ++m)
#pragma unroll
                    for (int n = 0; n < 2; ++n) acc[a][b][m][n] = (f32x4){0.f, 0.f, 0.f, 0.f};
        cur = nxt; cA = nA; cB = nB; ++ui;
    }
    PG8_WAIT_V(0);
    if (wr == 0) PG8_BAR;
    PG8_BAR;
    if constexpr (Epi::AFTER_DRAIN) { E.fused(acc, cur, wr, wc, fr, fq, lds, wid, lane); S.done(cur); }
    PG8_STAMP();
    if (STAMP && wid == 0) { stamps[lane] = lane < nts ? (((unsigned long long)(unsigned)ts_hi << 32) | (unsigned)ts_lo) : 0ull;
        if (lane == 62) stamps[62] = rt_entry; if (lane == 63) stamps[63] = (unsigned long long)wall_clock64(); }
#undef PG8_STAMP
#undef PG8_SA
#undef PG8_SB
#undef PG8_STAGE
#undef PG8_LDA
#undef PG8_LDB
#undef PG8_MMA
#undef PG8_WAIT_V
#undef PG8_WAIT_L
#undef PG8_BAR
#undef PG8_SCHED
}
}

#define LAS __attribute__((address_space(3)))
using pg8::bf16_t; using pg8::bf16x8; using pg8::f32x4; using pg8::u32x4;
typedef short bf16x4 __attribute__((ext_vector_type(4)));
typedef unsigned u32x2 __attribute__((ext_vector_type(2)));
typedef float f32x2v __attribute__((ext_vector_type(2)));
constexpr int NTOK = 12288, NPROMPT = 4096, DM = 1024;
constexpr int LDS_BYTES = 147456;
constexpr float EPSV = 1e-6f;
constexpr size_t WS_PROJ = 0;
constexpr size_t WS_YCAT = 176160768;
constexpr size_t WS_WIN  = WS_YCAT + 50331648;
constexpr size_t WS_WOUT = WS_WIN + 14680064;
constexpr size_t WS_STATS = WS_WOUT + 4194304;
constexpr size_t WS_MOD = WS_STATS + 3145728;
constexpr size_t WS_LB = WS_MOD + 245760;
constexpr size_t WS_BAR = WS_LB + 16384;
constexpr size_t WS_END = WS_BAR + 16384;

struct Params {
    const float *x_prompt, *x_sample, *c, *state_hgrn, *c_ctx, *w_ada, *b_ada, *g_pre, *g_post, *w_in_ab, *w_out_ab, *lb_logits, *g_onorm, *w_pool, *pool_scale,
        *w_in_c, *w_out_c, *ln_g, *ln_b, *w_sp, *b_sp;
    float* out; unsigned char* ws;
};

__device__ __forceinline__ float bf2f(bf16_t b) { return __uint_as_float(((unsigned)b) << 16); }
__device__ __forceinline__ bf16_t f2bf(float f) { unsigned u = __float_as_uint(f); u += 0x7FFFu + ((u >> 16) & 1u); return (bf16_t)(u >> 16); }
__device__ __forceinline__ float silu_f(float x) { return x / (1.f + __expf(-x)); }
__device__ __forceinline__ float wave_sum(float v) { v += __shfl_xor(v, 1); v += __shfl_xor(v, 2); v += __shfl_xor(v, 4); v += __shfl_xor(v, 8); v += __shfl_xor(v, 16); v += __shfl_xor(v, 32); return v; }

#define XB_TMO      128
#define XB_XCNT(j)  (256  + 64 * (j))
#define XB_XSUB(j)  (1280 + 64 * (j))
#define XB_XGEN(j)  (2304 + 64 * (j))
#define XB_TOP      3328
#define XB_TOPGEN   3392
#define XCD_BAR_WORDS 3456
#define XB_SPIN_CAP (1u << 20)
__device__ __forceinline__ unsigned xb_ld(unsigned* p)              { return __hip_atomic_load(p, __ATOMIC_RELAXED, __HIP_MEMORY_SCOPE_AGENT); }
__device__ __forceinline__ unsigned xb_add(unsigned* p, unsigned v) { return __hip_atomic_fetch_add(p, v, __ATOMIC_RELAXED, __HIP_MEMORY_SCOPE_AGENT); }
__device__ __forceinline__ unsigned xb_xcc_id() { return (unsigned)__builtin_amdgcn_s_getreg((3 << 11) | 20) & 0xFu; }
#define XB_SPIN(cond, bar) do { unsigned _sp = 0; while (cond) { __builtin_amdgcn_s_sleep(1); \
    if ((++_sp & 255u) == 0u) { if (xb_ld(&(bar)[XB_TMO])) break; if (_sp > XB_SPIN_CAP) { atomicAdd(&(bar)[XB_TMO], 1u); break; } } } } while (0)
struct XcdBarrier { unsigned* bar; unsigned x; volatile LAS unsigned* st; };
__device__ __forceinline__ XcdBarrier xcd_barrier_post(unsigned* bar, volatile LAS unsigned* st) {
    XcdBarrier b; b.bar = bar; b.x = xb_xcc_id(); b.st = st;
    if (threadIdx.x == 0) (void)xb_add(&bar[XB_XCNT(b.x)], 1u);
    return b;
}
__device__ __forceinline__ void xcd_barrier_complete(unsigned* bar, unsigned x, unsigned& nloc, unsigned& nx) {
    const unsigned G = gridDim.x * gridDim.y * gridDim.z;
    unsigned sum, cnt, mine, sp = 0u;
    for (;;) {
        sum = 0u; cnt = 0u; mine = 0u;
#pragma unroll
        for (unsigned j = 0; j < 16; ++j) { const unsigned c = xb_ld(&bar[XB_XCNT(j)]); sum += c; cnt += (c > 0u) ? 1u : 0u; mine = (j == x) ? c : mine; }
        if (sum == G) break;
        __builtin_amdgcn_s_sleep(1);
        if ((++sp & 255u) == 0u) { if (xb_ld(&bar[XB_TMO])) break; if (sp > XB_SPIN_CAP) { atomicAdd(&bar[XB_TMO], 1u); break; } }
    }
    nloc = mine > 0u ? mine : 1u; nx = cnt > 0u ? cnt : 1u;
}
__device__ __forceinline__ void xcd_barrier(const XcdBarrier& b) {
    asm volatile("s_waitcnt vmcnt(0)" ::: "memory");
    __syncthreads();
    if (threadIdx.x == 0) {
        unsigned* bar = b.bar;
        __builtin_amdgcn_s_waitcnt(0);
        unsigned nloc = b.st[0], nx = b.st[1];
        if (nloc == 0u) { xcd_barrier_complete(bar, b.x, nloc, nx); b.st[0] = nloc; b.st[1] = nx; }
        const unsigned old = xb_add(&bar[XB_XSUB(b.x)], 1u);
        const unsigned gen = old / nloc;
        if (old + 1u == (gen + 1u) * nloc) {
            __builtin_amdgcn_fence(__ATOMIC_RELEASE, "agent");
            asm volatile("s_waitcnt vmcnt(0)" ::: "memory");
            const unsigned og = xb_add(&bar[XB_TOP], 1u);
            const unsigned tg = og / nx;
            if (og + 1u == (tg + 1u) * nx) xb_add(&bar[XB_TOPGEN], 1u);
            else XB_SPIN(xb_ld(&bar[XB_TOPGEN]) == tg, bar);
            __builtin_amdgcn_fence(__ATOMIC_ACQUIRE, "agent");
            xb_add(&bar[XB_XGEN(b.x)], 1u);
            asm volatile("s_waitcnt vmcnt(0)" ::: "memory");
        } else {
            XB_SPIN(xb_ld(&bar[XB_XGEN(b.x)]) == gen, bar);
            __builtin_amdgcn_fence(__ATOMIC_ACQUIRE, "agent");
            asm volatile("s_waitcnt vmcnt(0)" ::: "memory");
        }
    }
    __syncthreads();
}

__device__ __forceinline__ void phase_mod(const Params& p, LAS unsigned char* lds) {
    int tid_l = threadIdx.x; asm volatile("" : "+v"(tid_l)); const int tid = tid_l;
    LAS float* sc = (LAS float*)lds;
    LAS float* red = sc + 5 * 1024;
    for (int i = tid; i < 5 * 1024; i += 512) { const int n = i >> 10, k = i & 1023; const float v = (n == 0) ? p.c_ctx[k] : p.c[(n - 1) * 1024 + k]; sc[i] = silu_f(v); }
    __syncthreads();
    float* mod = (float*)(p.ws + WS_MOD);
    for (int unit = blockIdx.x; unit < 192; unit += gridDim.x) {
        const int l = unit / 48, c0 = (unit % 48) * 64, cc = tid & 63, ks = tid >> 6;
        const float* w = p.w_ada + (size_t)l * 1024 * 3072 + c0 + cc;
        float a0 = 0.f, a1 = 0.f, a2 = 0.f, a3 = 0.f, a4 = 0.f;
#pragma unroll 8
        for (int k = ks * 128; k < ks * 128 + 128; ++k) { const float wv = w[(size_t)k * 3072];
            a0 += sc[k] * wv; a1 += sc[1024 + k] * wv; a2 += sc[2048 + k] * wv; a3 += sc[3072 + k] * wv; a4 += sc[4096 + k] * wv; }
        LAS float* r = red + (ks * 64 + cc) * 5; r[0] = a0; r[1] = a1; r[2] = a2; r[3] = a3; r[4] = a4;
        __syncthreads();
        if (tid < 320) { const int c2 = tid & 63, n = tid >> 6; float s = 0.f;
#pragma unroll
            for (int k8 = 0; k8 < 8; ++k8) s += red[(k8 * 64 + c2) * 5 + n];
            mod[(size_t)(l * 5 + n) * 3072 + c0 + c2] = s + p.b_ada[l * 3072 + c0 + c2]; }
        __syncthreads();
    }
    float* LB = (float*)(p.ws + WS_LB);
    for (int i = blockIdx.x * 512 + tid; i < 2048; i += gridDim.x * 512) { const float l0 = p.lb_logits[i], l1 = p.lb_logits[2048 + i];
        LB[i] = 0.f; LB[2048 + i] = 1.f / (1.f + __expf(l0 - l1)); }
}

__device__ __forceinline__ void phase_row(const Params& p, int l) {
    int tid_l = threadIdx.x; asm volatile("" : "+v"(tid_l)); const int tid = tid_l, lane = tid & 63, wv = tid >> 6;
    const float* mod = (const float*)(p.ws + WS_MOD);
    const float* ybuf = (const float*)(p.ws + WS_PROJ);
    bf16_t* hbuf = (bf16_t*)(p.ws + WS_YCAT);
    for (int row = blockIdx.x * 8 + wv; row < NTOK; row += gridDim.x * 8) {
        const int n = row < NPROMPT ? 0 : 1 + ((row - NPROMPT) >> 11);
        f32x4 x[4];
        const float* xsrc = (l == 0) ? (row < NPROMPT ? p.x_prompt + (size_t)row * DM : p.x_sample + (size_t)(row - NPROMPT) * DM) : p.out + (size_t)row * DM;
#pragma unroll
        for (int i = 0; i < 4; ++i) x[i] = *(const f32x4*)(xsrc + (i * 64 + lane) * 4);
        if (l > 0) {
            f32x4 y[4]; float ss = 0.f;
#pragma unroll
            for (int i = 0; i < 4; ++i) { y[i] = *(const f32x4*)(ybuf + (size_t)row * DM + (i * 64 + lane) * 4); ss += y[i][0] * y[i][0] + y[i][1] * y[i][1] + y[i][2] * y[i][2] + y[i][3] * y[i][3]; }
            ss = wave_sum(ss); const float r = rsqrtf(ss * (1.f / 1024.f) + EPSV);
            const float* gt = mod + (size_t)((l - 1) * 5 + n) * 3072 + 2048; const float* gp = p.g_post + (l - 1) * 1024;
#pragma unroll
            for (int i = 0; i < 4; ++i) { const int col = (i * 64 + lane) * 4; const f32x4 g = *(const f32x4*)(gt + col), q = *(const f32x4*)(gp + col); x[i] = x[i] + g * (y[i] * r * q); }
        }
#pragma unroll
        for (int i = 0; i < 4; ++i) *(f32x4*)(p.out + (size_t)row * DM + (i * 64 + lane) * 4) = x[i];
        if (l < 4) {
            float ss = 0.f;
#pragma unroll
            for (int i = 0; i < 4; ++i) ss += x[i][0] * x[i][0] + x[i][1] * x[i][1] + x[i][2] * x[i][2] + x[i][3] * x[i][3];
            ss = wave_sum(ss); const float r = rsqrtf(ss * (1.f / 1024.f) + EPSV);
            const float* sh = mod + (size_t)(l * 5 + n) * 3072; const float* scl = sh + 1024; const float* gp = p.g_pre + l * 1024;
#pragma unroll
            for (int i = 0; i < 4; ++i) { const int col = (i * 64 + lane) * 4; const f32x4 a = *(const f32x4*)(sh + col), s = *(const f32x4*)(scl + col), g = *(const f32x4*)(gp + col);
                const f32x4 hv = x[i] * r * g * (s + 1.f) + a; u32x2 w; w.x = pg8::cvt_pk_bf16(hv[0], hv[1]); w.y = pg8::cvt_pk_bf16(hv[2], hv[3]);
                *(u32x2*)(hbuf + (size_t)row * DM + col) = w; }
#ifdef DIAG_HROW
            if (l == DIAG_HROW) {
#pragma unroll
                for (int i = 0; i < 4; ++i) { const int col = (i * 64 + lane) * 4; const u32x2 w = *(const u32x2*)(hbuf + (size_t)row * DM + col);
                    f32x4 o; o[0] = __uint_as_float(w.x << 16); o[1] = __uint_as_float(w.x & 0xffff0000u); o[2] = __uint_as_float(w.y << 16); o[3] = __uint_as_float(w.y & 0xffff0000u);
                    *(f32x4*)(p.out + (size_t)row * DM + col) = o; } }
#endif
        }
    }
}

__device__ __forceinline__ void conv_tile(const float* W, int K, int N, bf16_t* Wt, int kt, int nt, LAS unsigned char* lds) {
    int tid_l = threadIdx.x; asm volatile("" : "+v"(tid_l)); const int tid = tid_l; LAS float* tile = (LAS float*)lds;
    const int k0 = kt * 64, n0 = nt * 64;
#pragma unroll
    for (int it = 0; it < 2; ++it) { const int r = it * 32 + (tid >> 4), c4 = (tid & 15) * 4; const f32x4 v = *(const f32x4*)(W + (size_t)(k0 + r) * N + n0 + c4);
        tile[r * 65 + c4] = v[0]; tile[r * 65 + c4 + 1] = v[1]; tile[r * 65 + c4 + 2] = v[2]; tile[r * 65 + c4 + 3] = v[3]; }
    __syncthreads();
    { const int nn = tid >> 3, k8 = (tid & 7) * 8; u32x4 w;
      w.x = pg8::cvt_pk_bf16(tile[(k8 + 0) * 65 + nn], tile[(k8 + 1) * 65 + nn]); w.y = pg8::cvt_pk_bf16(tile[(k8 + 2) * 65 + nn], tile[(k8 + 3) * 65 + nn]);
      w.z = pg8::cvt_pk_bf16(tile[(k8 + 4) * 65 + nn], tile[(k8 + 5) * 65 + nn]); w.w = pg8::cvt_pk_bf16(tile[(k8 + 6) * 65 + nn], tile[(k8 + 7) * 65 + nn]);
      *(u32x4*)(Wt + (size_t)(n0 + nn) * K + k0 + k8) = w; }
    __syncthreads();
}
__device__ __forceinline__ void fold_unit(const Params& p, int j, int fu, LAS unsigned char* lds) {
    int tid_l = threadIdx.x; asm volatile("" : "+v"(tid_l)); const int tid = tid_l; const int g = fu >> 5, et = (fu >> 3) & 3, kt = fu & 7; const int e0 = et * 64, k0 = kt * 128;
    LAS float* As = (LAS float*)lds;
    LAS float* Bs = As + 32 * 64;
    const float* wp = p.w_pool + (size_t)(j * 4 + g) * 65536; const float* wi = p.w_in_ab + (size_t)j * 1024 * 7168 + 5120 + g * 256;
    const int e4 = (tid & 15) * 4, k4 = (tid >> 4) * 4;
    float acc[4][4];
#pragma unroll
    for (int i = 0; i < 4; ++i)
#pragma unroll
        for (int q = 0; q < 4; ++q) acc[i][q] = 0.f;
    for (int c0 = 0; c0 < 256; c0 += 32) {
        { const int r = tid >> 4, c4 = (tid & 15) * 4; const f32x4 v = *(const f32x4*)(wp + (size_t)(c0 + r) * 256 + e0 + c4); *(LAS f32x4*)(As + r * 64 + c4) = v; }
        { const int kk = tid >> 2, cc = (tid & 3) * 8; const float* src = wi + (size_t)(k0 + kk) * 7168 + c0 + cc; const f32x4 v0 = *(const f32x4*)src, v1 = *(const f32x4*)(src + 4);
          LAS float* d = Bs + kk * 33 + cc; d[0] = v0[0]; d[1] = v0[1]; d[2] = v0[2]; d[3] = v0[3]; d[4] = v1[0]; d[5] = v1[1]; d[6] = v1[2]; d[7] = v1[3]; }
        __syncthreads();
#pragma unroll 8
        for (int c = 0; c < 32; ++c) { const f32x4 a = *(LAS f32x4*)(As + c * 64 + e4);
#pragma unroll
            for (int i = 0; i < 4; ++i) { const float bv = Bs[(k4 + i) * 33 + c]; acc[i][0] += bv * a[0]; acc[i][1] += bv * a[1]; acc[i][2] += bv * a[2]; acc[i][3] += bv * a[3]; } }
        __syncthreads();
    }
    bf16_t* Wt = (bf16_t*)(p.ws + WS_WIN);
#pragma unroll
    for (int q = 0; q < 4; ++q) { const int e = g * 256 + e0 + e4 + q; const float ps = p.pool_scale[j * 1024 + e];
        u32x2 w; w.x = pg8::cvt_pk_bf16(acc[0][q] * ps, acc[1][q] * ps); w.y = pg8::cvt_pk_bf16(acc[2][q] * ps, acc[3][q] * ps);
        *(u32x2*)(Wt + (size_t)(5120 + e) * 1024 + k0 + k4) = w; }
}
__device__ __forceinline__ void phase_conv(const Params& p, int l, LAS unsigned char* lds) {
    const int j = l >> 1; const bool ab = (l & 1) == 0;
    const float* Win = ab ? p.w_in_ab + (size_t)j * 1024 * 7168 : p.w_in_c + (size_t)j * 1024 * 6144; const int Nin = ab ? 7168 : 6144;
    const float* Wout = ab ? p.w_out_ab + (size_t)j * 2048 * 1024 : p.w_out_c + (size_t)j * 2048 * 1024;
    const int n_in = 1536, n_out = 512, n_fold = ab ? 128 : 0;
    for (int u = blockIdx.x; u < n_in + n_out + n_fold; u += gridDim.x) {
        if (u < n_in) { int nt = u >> 4; const int kt = u & 15; if (ab && nt >= 80) nt += 16; conv_tile(Win, 1024, Nin, (bf16_t*)(p.ws + WS_WIN), kt, nt, lds); }
        else if (u < n_in + n_out) { const int v = u - n_in; conv_tile(Wout, 2048, 1024, (bf16_t*)(p.ws + WS_WOUT), v & 31, v >> 5, lds); }
        else fold_unit(p, j, u - n_in - n_out, lds);
    }
}

constexpr int HG_QS = 0, HG_KS = 8704, HG_KT = 17408, HG_VT = 27648, HG_FAC = 37888, HG_BUF = 39424, HG_TOT = 2 * HG_BUF;
__device__ __forceinline__ float clampe(float v) { return fminf(fmaxf(v, -80.f), 80.f); }
__device__ __forceinline__ void hgrn_unit(const Params& p, LAS unsigned char* lds, int j, bool sample, int b, int h, int dir) {
    int tid_l = threadIdx.x; asm volatile("" : "+v"(tid_l)); const int tid = tid_l, lane = tid & 63, w = tid >> 6, fr = lane & 15, hq = lane >> 4;
    const int T = sample ? 2048 : 256, nch = T >> 5;
    const size_t rowbase = sample ? (size_t)NPROMPT + (size_t)b * 2048 : (size_t)b * 256;
    bf16_t* proj = (bf16_t*)(p.ws + WS_PROJ);
    const int d = tid & 127, tq = tid >> 7;
    const float lbv = ((const float*)(p.ws + WS_LB))[(j * 2 + dir) * 1024 + h * 128 + d], oml = 1.f - lbv;
    f32x4 S[8];
    if (sample) { const float* s0 = p.state_hgrn + ((((size_t)b * 2 + j) * 2 + dir) * 8 + h) * 16384;
#pragma unroll
        for (int dt = 0; dt < 8; ++dt)
#pragma unroll
            for (int r = 0; r < 4; ++r) S[dt][r] = s0[(16 * dt + 4 * hq + r) * 128 + 16 * w + fr];
    } else {
#pragma unroll
        for (int dt = 0; dt < 8; ++dt) S[dt] = (f32x4){0.f, 0.f, 0.f, 0.f};
    }
    LAS float* TOT = (LAS float*)(lds + HG_TOT);
    bf16_t nq[8], nf[8], nv[8];
    const size_t cq = (size_t)h * 128 + d, cf = 1024 * (1 + dir) + (size_t)h * 128 + d, cv = 3072 + (size_t)h * 128 + d;
#define HG_LOAD(c) do { _Pragma("unroll") for (int i = 0; i < 8; ++i) { const int pi = (c) * 32 + 8 * tq + i; const size_t row = rowbase + (dir ? (T - 1 - pi) : pi); \
        const bf16_t* rp = proj + row * 7168; nq[i] = rp[cq]; nf[i] = rp[cf]; nv[i] = rp[cv]; } } while (0)
    HG_LOAD(0);
    for (int c = 0; c < nch; ++c) {
        LAS unsigned char* buf = lds + (c & 1) * HG_BUF;
        LAS bf16_t* QS = (LAS bf16_t*)(buf + HG_QS); LAS bf16_t* KS = (LAS bf16_t*)(buf + HG_KS); LAS bf16_t* KT = (LAS bf16_t*)(buf + HG_KT); LAS bf16_t* VT = (LAS bf16_t*)(buf + HG_VT);
        LAS float* FAC = (LAS float*)(buf + HG_FAC);
        float Bc[8], kk[8], qs[8]; float cs = 0.f;
#pragma unroll
        for (int i = 0; i < 8; ++i) { const float x = bf2f(nf[i]); const float e = __expf(-x); const float inv = 1.f / (1.f + e); const float sg = inv, om = e * inv;
            const float f = lbv + oml * sg; kk[i] = oml * om; cs += __logf(f); Bc[i] = cs; qs[i] = silu_f(bf2f(nq[i])); }
        TOT[tq * 128 + d] = cs;
        __syncthreads();
        const float t0 = TOT[d], t1 = TOT[128 + d], t2 = TOT[256 + d], t3 = TOT[384 + d];
        const float off = (tq > 0 ? t0 : 0.f) + (tq > 1 ? t1 : 0.f) + (tq > 2 ? t2 : 0.f);
        const float R = t0 + t1, Bl = R + t2 + t3;
#pragma unroll
        for (int i = 0; i < 8; ++i) { const int tl = 8 * tq + i; const float Bt = off + Bc[i];
            const float eq = __expf(clampe(Bt - R)), ek = __expf(clampe(R - Bt));
            const bf16_t qb = f2bf(qs[i] * eq), kb = f2bf(kk[i] * ek);
            QS[tl * 136 + d] = qb; KS[tl * 136 + d] = kb; KT[d * 40 + tl] = kb; VT[d * 40 + tl] = nv[i]; }
        if (tq == 0) { FAC[d] = __expf(R); FAC[128 + d] = __expf(Bl); FAC[256 + d] = __expf(Bl - R); }
        if (c + 1 < nch) HG_LOAD(c + 1);
        __syncthreads();
        f32x4 s00 = {0.f, 0.f, 0.f, 0.f}, s01 = s00, s11 = s00;
#pragma unroll
        for (int ks = 0; ks < 4; ++ks) {
            const bf16x8 a0 = *(LAS bf16x8*)(KS + fr * 136 + ks * 32 + hq * 8), a1 = *(LAS bf16x8*)(KS + (16 + fr) * 136 + ks * 32 + hq * 8);
            const bf16x8 b0 = *(LAS bf16x8*)(QS + fr * 136 + ks * 32 + hq * 8), b1 = *(LAS bf16x8*)(QS + (16 + fr) * 136 + ks * 32 + hq * 8);
            s00 = __builtin_amdgcn_mfma_f32_16x16x32_bf16(a0, b0, s00, 0, 0, 0);
            s01 = __builtin_amdgcn_mfma_f32_16x16x32_bf16(a0, b1, s01, 0, 0, 0);
            s11 = __builtin_amdgcn_mfma_f32_16x16x32_bf16(a1, b1, s11, 0, 0, 0);
        }
#pragma unroll
        for (int r = 0; r < 4; ++r) { const bool keep = fr >= 4 * hq + r; s00[r] = keep ? s00[r] : 0.f; s11[r] = keep ? s11[r] : 0.f; }
        u32x4 pa0, pa1;
        pa0.x = pg8::cvt_pk_bf16(s00[0], s00[1]); pa0.y = pg8::cvt_pk_bf16(s00[2], s00[3]); pa0.z = 0u; pa0.w = 0u;
        pa1.x = pg8::cvt_pk_bf16(s01[0], s01[1]); pa1.y = pg8::cvt_pk_bf16(s01[2], s01[3]); pa1.z = pg8::cvt_pk_bf16(s11[0], s11[1]); pa1.w = pg8::cvt_pk_bf16(s11[2], s11[3]);
        const LAS bf16_t* vrow = VT + (16 * w + fr) * 40;
        u32x4 vb; { const u32x2 lo = *(const LAS u32x2*)(vrow + 4 * hq), hi = *(const LAS u32x2*)(vrow + 16 + 4 * hq); vb.x = lo.x; vb.y = lo.y; vb.z = hi.x; vb.w = hi.y; }
        f32x4 o0 = {0.f, 0.f, 0.f, 0.f}, o1 = o0;
        o0 = __builtin_amdgcn_mfma_f32_16x16x32_bf16(__builtin_bit_cast(bf16x8, pa0), __builtin_bit_cast(bf16x8, vb), o0, 0, 0, 0);
        o1 = __builtin_amdgcn_mfma_f32_16x16x32_bf16(__builtin_bit_cast(bf16x8, pa1), __builtin_bit_cast(bf16x8, vb), o1, 0, 0, 0);
#pragma unroll
        for (int ks = 0; ks < 4; ++ks) {
            const f32x4 e0 = *(LAS f32x4*)(FAC + 32 * ks + 4 * hq), e1 = *(LAS f32x4*)(FAC + 32 * ks + 16 + 4 * hq);
            const f32x4 x0 = S[2 * ks] * e0, x1 = S[2 * ks + 1] * e1;
            u32x4 sb; sb.x = pg8::cvt_pk_bf16(x0[0], x0[1]); sb.y = pg8::cvt_pk_bf16(x0[2], x0[3]); sb.z = pg8::cvt_pk_bf16(x1[0], x1[1]); sb.w = pg8::cvt_pk_bf16(x1[2], x1[3]);
            const LAS bf16_t* q0 = QS + fr * 136 + 32 * ks + 4 * hq; const LAS bf16_t* q1 = q0 + 16 * 136;
            u32x4 qa0, qa1; { const u32x2 lo = *(const LAS u32x2*)q0, hi = *(const LAS u32x2*)(q0 + 16); qa0.x = lo.x; qa0.y = lo.y; qa0.z = hi.x; qa0.w = hi.y; }
            { const u32x2 lo = *(const LAS u32x2*)q1, hi = *(const LAS u32x2*)(q1 + 16); qa1.x = lo.x; qa1.y = lo.y; qa1.z = hi.x; qa1.w = hi.y; }
            o0 = __builtin_amdgcn_mfma_f32_16x16x32_bf16(__builtin_bit_cast(bf16x8, qa0), __builtin_bit_cast(bf16x8, sb), o0, 0, 0, 0);
            o1 = __builtin_amdgcn_mfma_f32_16x16x32_bf16(__builtin_bit_cast(bf16x8, qa1), __builtin_bit_cast(bf16x8, sb), o1, 0, 0, 0);
        }
        { const bf16x8 vb8 = *(const LAS bf16x8*)(vrow + 8 * hq);
#pragma unroll
          for (int dt = 0; dt < 8; ++dt) {
              const bf16x8 ka = *(const LAS bf16x8*)(KT + (16 * dt + fr) * 40 + 8 * hq);
              f32x4 t = {0.f, 0.f, 0.f, 0.f};
              t = __builtin_amdgcn_mfma_f32_16x16x32_bf16(ka, vb8, t, 0, 0, 0);
              const f32x4 el = *(LAS f32x4*)(FAC + 128 + 16 * dt + 4 * hq), er = *(LAS f32x4*)(FAC + 256 + 16 * dt + 4 * hq);
              S[dt] = S[dt] * el + er * t;
          } }
#pragma unroll
        for (int r = 0; r < 4; ++r) {
            { const int pi = c * 32 + 4 * hq + r; const size_t row = rowbase + (dir ? (T - 1 - pi) : pi); proj[row * 7168 + 1024 * (1 + dir) + h * 128 + 16 * w + fr] = f2bf(o0[r]); }
            { const int pi = c * 32 + 16 + 4 * hq + r; const size_t row = rowbase + (dir ? (T - 1 - pi) : pi); proj[row * 7168 + 1024 * (1 + dir) + h * 128 + 16 * w + fr] = f2bf(o1[r]); }
        }
    }
#undef HG_LOAD
    if (!sample) { float* so = p.out + (size_t)NTOK * DM + ((((size_t)b * 2 + j) * 2 + dir) * 8 + h) * 16384;
#pragma unroll
        for (int dt = 0; dt < 8; ++dt)
#pragma unroll
            for (int r = 0; r < 4; ++r) so[(16 * dt + 4 * hq + r) * 128 + 16 * w + fr] = S[dt][r];
    }
    __syncthreads();
}

template <int W> __device__ __forceinline__ void pool_prompt_unit(const Params& p, int b, int slab) {
    int tid_l = threadIdx.x; asm volatile("" : "+v"(tid_l)); const int tid = tid_l, cp = tid & 31, seg = tid >> 5; const int ch = slab * 64 + 2 * cp, t0 = seg * 16;
    const bf16_t* proj = (const bf16_t*)(p.ws + WS_PROJ); bf16_t* ycat = (bf16_t*)(p.ws + WS_YCAT);
    float xa[16 + W], xb[16 + W];
#pragma unroll
    for (int i = 0; i < 16 + W; ++i) { const int t = t0 - W / 2 + i; float a = 0.f, bq = 0.f;
        if (t >= 0 && t < 256) { const unsigned v = *(const unsigned*)(proj + ((size_t)b * 256 + t) * 7168 + 5120 + ch); a = __uint_as_float(v << 16); bq = __uint_as_float(v & 0xffff0000u); }
        xa[i] = a; xb[i] = bq; }
#pragma unroll
    for (int k = 0; k < 16; ++k) { const int t = t0 + k; float sa = 0.f, sb = 0.f;
#pragma unroll
        for (int i = 0; i < W; ++i) { sa += xa[k + i]; sb += xb[k + i]; }
        const int lo = max(t - W / 2, 0), hi = min(t - W / 2 + W, 256); const float inv = 1.f / (float)(hi - lo);
        const size_t row = (size_t)b * 256 + t; const unsigned gv = *(const unsigned*)(proj + row * 7168 + 6144 + ch);
        const float ya = (sa * inv - xa[k + W / 2]) * silu_f(__uint_as_float(gv << 16)), yb = (sb * inv - xb[k + W / 2]) * silu_f(__uint_as_float(gv & 0xffff0000u));
        *(unsigned*)(ycat + row * 2048 + 1024 + ch) = pg8::cvt_pk_bf16(ya, yb); }
}
template <int W> __device__ __forceinline__ void pool_sample_unit(const Params& p, LAS unsigned char* lds, int b, int g, int slab) {
    int tid_l = threadIdx.x; asm volatile("" : "+v"(tid_l)); const int tid = tid_l; const int chb = g * 256 + slab * 16;
    const bf16_t* proj = (const bf16_t*)(p.ws + WS_PROJ); bf16_t* ycat = (bf16_t*)(p.ws + WS_YCAT);
    LAS float* buf = (LAS float*)lds;
    const size_t rowb = (size_t)NPROMPT + (size_t)b * 2048;
    { const int cp = tid & 7, col = tid >> 3; float pa[33], pb[33]; pa[0] = 0.f; pb[0] = 0.f;
#pragma unroll
      for (int r = 0; r < 32; ++r) { const unsigned v = *(const unsigned*)(proj + (rowb + r * 64 + col) * 7168 + 5120 + chb + 2 * cp);
          pa[r + 1] = pa[r] + __uint_as_float(v << 16); pb[r + 1] = pb[r] + __uint_as_float(v & 0xffff0000u); }
#pragma unroll
      for (int r = 0; r < 32; ++r) { const int lo = (r - W / 2) > 0 ? (r - W / 2) : 0, hi = (r - W / 2 + W) < 32 ? (r - W / 2 + W) : 32; const float inv = 1.f / (float)(hi - lo);
          LAS float* dst = buf + r * 1040 + col * 16 + 2 * cp; dst[0] = (pa[hi] - pa[lo]) * inv; dst[1] = (pb[hi] - pb[lo]) * inv; } }
    __syncthreads();
    { const int chl = tid & 15, r = tid >> 4; float pc[65]; pc[0] = 0.f;
#pragma unroll
      for (int col = 0; col < 64; ++col) pc[col + 1] = pc[col] + buf[r * 1040 + col * 16 + chl];
#pragma unroll
      for (int col = 0; col < 64; ++col) { const int lo = (col - W / 2) > 0 ? (col - W / 2) : 0, hi = (col - W / 2 + W) < 64 ? (col - W / 2 + W) : 64; const float inv = 1.f / (float)(hi - lo);
          const size_t row = rowb + r * 64 + col; const float z = bf2f(proj[row * 7168 + 5120 + chb + chl]), gt = bf2f(proj[row * 7168 + 6144 + chb + chl]);
          ycat[row * 2048 + 1024 + chb + chl] = f2bf(((pc[hi] - pc[lo]) * inv - z) * silu_f(gt)); } }
    __syncthreads();
}

__device__ __forceinline__ void pool_unit(const Params& p, LAS unsigned char* lds, int u) {
    if (u < 64) { const int b = u >> 4, g = (u >> 2) & 3, sq = u & 3;
        for (int s4 = 0; s4 < 4; ++s4) { const int slab = sq * 4 + s4;
            if (g == 0) pool_sample_unit<2>(p, lds, b, g, slab); else if (g == 1) pool_sample_unit<4>(p, lds, b, g, slab); else if (g == 2) pool_sample_unit<8>(p, lds, b, g, slab); else pool_sample_unit<16>(p, lds, b, g, slab); } }
    else { const int v = u - 64, b = v >> 4, slab = v & 15, g = slab >> 2;
        if (g == 0) pool_prompt_unit<2>(p, b, slab); else if (g == 1) pool_prompt_unit<4>(p, b, slab); else if (g == 2) pool_prompt_unit<8>(p, b, slab); else pool_prompt_unit<16>(p, b, slab); }
}
__device__ __forceinline__ void phase_mix_ab(const Params& p, int j, LAS unsigned char* lds) {
    const int bid = blockIdx.x, G = gridDim.x;
    if (G >= 128) {
        if (bid < 64) { hgrn_unit(p, lds, j, true, bid >> 4, (bid >> 1) & 7, bid & 1); return; }
        const int idx = bid - 64, nS = G - 64;
        for (int v = idx; v < 256; v += nS) hgrn_unit(p, lds, j, false, v >> 4, (v >> 1) & 7, v & 1);
        for (int u = nS - 1 - idx; u < 320; u += nS) pool_unit(p, lds, u);
    } else {
        for (int u = bid; u < 320; u += G) { if (u < 64) hgrn_unit(p, lds, j, true, u >> 4, (u >> 1) & 7, u & 1); else { const int v = u - 64; hgrn_unit(p, lds, j, false, v >> 4, (v >> 1) & 7, v & 1); } }
        for (int u = bid; u < 320; u += G) pool_unit(p, lds, u);
    }
}
__device__ __forceinline__ void phase_combine(const Params& p, int j) {
    int tid_l = threadIdx.x; asm volatile("" : "+v"(tid_l)); const int tid = tid_l, lane = tid & 63, wv = tid >> 6; const int hd = lane >> 3, e0 = (lane & 7) * 16;
    const bf16_t* proj = (const bf16_t*)(p.ws + WS_PROJ); bf16_t* ycat = (bf16_t*)(p.ws + WS_YCAT);
    float gn[16];
#pragma unroll
    for (int i = 0; i < 16; ++i) gn[i] = p.g_onorm[j * 128 + e0 + i];
    for (int tok = blockIdx.x * 8 + wv; tok < NTOK; tok += gridDim.x * 8) {
        const bf16_t* rp = proj + (size_t)tok * 7168 + hd * 128 + e0;
        const u32x4 f0 = *(const u32x4*)(rp + 1024), f1 = *(const u32x4*)(rp + 1024 + 8), b0 = *(const u32x4*)(rp + 2048), b1 = *(const u32x4*)(rp + 2048 + 8), g0 = *(const u32x4*)(rp + 4096), g1 = *(const u32x4*)(rp + 4096 + 8);
        float s[16], gt[16]; float ss = 0.f;
#pragma unroll
        for (int i = 0; i < 4; ++i) { s[2 * i] = __uint_as_float(f0[i] << 16) + __uint_as_float(b0[i] << 16); s[2 * i + 1] = __uint_as_float(f0[i] & 0xffff0000u) + __uint_as_float(b0[i] & 0xffff0000u);
            s[8 + 2 * i] = __uint_as_float(f1[i] << 16) + __uint_as_float(b1[i] << 16); s[8 + 2 * i + 1] = __uint_as_float(f1[i] & 0xffff0000u) + __uint_as_float(b1[i] & 0xffff0000u);
            gt[2 * i] = __uint_as_float(g0[i] << 16); gt[2 * i + 1] = __uint_as_float(g0[i] & 0xffff0000u); gt[8 + 2 * i] = __uint_as_float(g1[i] << 16); gt[8 + 2 * i + 1] = __uint_as_float(g1[i] & 0xffff0000u); }
#pragma unroll
        for (int i = 0; i < 16; ++i) ss += s[i] * s[i];
        ss += __shfl_xor(ss, 1); ss += __shfl_xor(ss, 2); ss += __shfl_xor(ss, 4);
        const float r = rsqrtf(ss * (1.f / 128.f) + EPSV);
        u32x4 w0, w1;
#pragma unroll
        for (int i = 0; i < 4; ++i) { w0[i] = pg8::cvt_pk_bf16(s[2 * i] * r * gn[2 * i] * silu_f(gt[2 * i]), s[2 * i + 1] * r * gn[2 * i + 1] * silu_f(gt[2 * i + 1]));
            w1[i] = pg8::cvt_pk_bf16(s[8 + 2 * i] * r * gn[8 + 2 * i] * silu_f(gt[8 + 2 * i]), s[8 + 2 * i + 1] * r * gn[8 + 2 * i + 1] * silu_f(gt[8 + 2 * i + 1])); }
        bf16_t* yp = ycat + (size_t)tok * 2048 + hd * 128 + e0; *(u32x4*)yp = w0; *(u32x4*)(yp + 8) = w1;
    }
}

constexpr int CM_VNT = 0, CM_WS = 69632, CM_MU = 104448;
__device__ __forceinline__ void phase_mix_c(const Params& p, int j, LAS unsigned char* lds) {
    int tid_l = threadIdx.x; asm volatile("" : "+v"(tid_l)); const int tid = tid_l, lane = tid & 63, w = tid >> 6, fr = lane & 15, hq = lane >> 4;
    const bf16_t* proj = (const bf16_t*)(p.ws + WS_PROJ); bf16_t* ycat = (bf16_t*)(p.ws + WS_YCAT); const float* stats = (const float*)(p.ws + WS_STATS);
    LAS bf16_t* VNT = (LAS bf16_t*)(lds + CM_VNT); LAS bf16_t* WSL = (LAS bf16_t*)(lds + CM_WS); LAS f32x2v* MU = (LAS f32x2v*)(lds + CM_MU);
    for (int unit = blockIdx.x; unit < 768; unit += gridDim.x) {
        const int g = unit & 7, n = unit >> 3; const size_t row0 = (size_t)n * 128;
        if (tid < 128) { float s = 0.f, q = 0.f;
#pragma unroll
            for (int i = 0; i < 8; ++i) { const float* sp = stats + ((size_t)i * NTOK + row0 + tid) * 8; const f32x4 v = *(const f32x4*)sp, v2 = *(const f32x4*)(sp + 4); s += (v[0] + v[2]) + (v2[0] + v2[2]); q += (v[1] + v[3]) + (v2[1] + v2[3]); }
            const float mean = s * (1.f / 2048.f); const float var = fmaxf(q * (1.f / 2048.f) - mean * mean, 0.f); MU[tid] = (f32x2v){mean, rsqrtf(var + EPSV)}; }
        { const int t = tid >> 2, s0 = (tid & 3) * 32; const float* src = p.w_sp + ((size_t)(j * 8 + g) * 128 + t) * 128 + s0;
#pragma unroll
          for (int i = 0; i < 4; ++i) { const f32x4 a = *(const f32x4*)(src + 8 * i), bq = *(const f32x4*)(src + 8 * i + 4);
              u32x4 wv; wv.x = pg8::cvt_pk_bf16(a[0], a[1]); wv.y = pg8::cvt_pk_bf16(a[2], a[3]); wv.z = pg8::cvt_pk_bf16(bq[0], bq[1]); wv.w = pg8::cvt_pk_bf16(bq[2], bq[3]);
              *(LAS u32x4*)(WSL + t * 136 + s0 + 8 * i) = wv; } }
        __syncthreads();
        { const int s = tid >> 2, cq = (tid & 3) * 64; const f32x2v mu = MU[s]; const bf16_t* src = proj + (row0 + s) * 6144 + 2048 + g * 256 + cq;
          const float* lg = p.ln_g + j * 2048 + g * 256 + cq; const float* lb = p.ln_b + j * 2048 + g * 256 + cq;
#pragma unroll
          for (int i = 0; i < 8; ++i) { const u32x4 v = *(const u32x4*)(src + 8 * i);
#pragma unroll
              for (int q = 0; q < 4; ++q) { const int c = cq + 8 * i + 2 * q; const float v0 = __uint_as_float(v[q] << 16), v1 = __uint_as_float(v[q] & 0xffff0000u);
                  VNT[c * 136 + s] = f2bf((v0 - mu.x) * mu.y * lg[8 * i + 2 * q] + lb[8 * i + 2 * q]);
                  VNT[(c + 1) * 136 + s] = f2bf((v1 - mu.x) * mu.y * lg[8 * i + 2 * q + 1] + lb[8 * i + 2 * q + 1]); } } }
        __syncthreads();
        bf16x8 af[2][4];
#pragma unroll
        for (int ct = 0; ct < 2; ++ct)
#pragma unroll
            for (int ks = 0; ks < 4; ++ks) af[ct][ks] = *(const LAS bf16x8*)(VNT + (32 * w + 16 * ct + fr) * 136 + 32 * ks + 8 * hq);
        const float* bsp = p.b_sp + (size_t)(j * 8 + g) * 128;
#pragma unroll 2
        for (int tt = 0; tt < 8; ++tt) {
            f32x4 a0 = {0.f, 0.f, 0.f, 0.f}, a1 = a0;
#pragma unroll
            for (int ks = 0; ks < 4; ++ks) { const bf16x8 bf = *(const LAS bf16x8*)(WSL + (16 * tt + fr) * 136 + 32 * ks + 8 * hq);
                a0 = __builtin_amdgcn_mfma_f32_16x16x32_bf16(af[0][ks], bf, a0, 0, 0, 0); a1 = __builtin_amdgcn_mfma_f32_16x16x32_bf16(af[1][ks], bf, a1, 0, 0, 0); }
            const size_t row = row0 + 16 * tt + fr; const float bs = bsp[16 * tt + fr];
#pragma unroll
            for (int ct = 0; ct < 2; ++ct) { const f32x4 a = ct ? a1 : a0; const int c = g * 256 + 32 * w + 16 * ct + 4 * hq;
                const u32x2 uu = *(const u32x2*)(proj + row * 6144 + c), gg = *(const u32x2*)(proj + row * 6144 + 4096 + c);
                const float y0 = __uint_as_float(uu.x << 16) * (a[0] + bs) * silu_f(__uint_as_float(gg.x << 16)), y1 = __uint_as_float(uu.x & 0xffff0000u) * (a[1] + bs) * silu_f(__uint_as_float(gg.x & 0xffff0000u));
                const float y2 = __uint_as_float(uu.y << 16) * (a[2] + bs) * silu_f(__uint_as_float(gg.y << 16)), y3 = __uint_as_float(uu.y & 0xffff0000u) * (a[3] + bs) * silu_f(__uint_as_float(gg.y & 0xffff0000u));
                u32x2 o; o.x = pg8::cvt_pk_bf16(y0, y1); o.y = pg8::cvt_pk_bf16(y2, y3); *(u32x2*)(ycat + row * 2048 + c) = o; }
        }
        __syncthreads();
    }
}

#ifdef DIAG_L
__device__ __forceinline__ void diag_dump_bf16(const Params& p, const bf16_t* buf, int K) {
    for (size_t i = (size_t)blockIdx.x * 512 + threadIdx.x; i < (size_t)NTOK * DM; i += (size_t)gridDim.x * 512) { float a = 0.f; for (int k = 0; k < K; ++k) a += bf2f(buf[i + (size_t)k * NTOK * DM]); p.out[i] = (float)((__float_as_uint(a) * 2654435761u) >> 16) * (1.f / 65536.f); }
}
__device__ __forceinline__ void diag_dump_f32(const Params& p, const float* buf) {
    for (size_t i = (size_t)blockIdx.x * 512 + threadIdx.x; i < (size_t)NTOK * DM; i += (size_t)gridDim.x * 512) p.out[i] = (float)((__float_as_uint(buf[i]) * 2654435761u) >> 16) * (1.f / 65536.f);
}
#endif
__global__ void __launch_bounds__(512, 2) mega_fwd(Params p) {
    extern __shared__ __attribute__((aligned(16))) unsigned char shm[];
    LAS unsigned char* lds = (LAS unsigned char*)shm;
    volatile LAS unsigned* bst = (volatile LAS unsigned*)(lds + LDS_BYTES - 16);
    if (threadIdx.x < 4) bst[threadIdx.x] = 0u;
    __syncthreads();
    XcdBarrier bar = xcd_barrier_post((unsigned*)(p.ws + WS_BAR), bst);
    phase_mod(p, lds);
    cg::this_grid().sync();
    xcd_barrier(bar);
    bf16_t* hbuf = (bf16_t*)(p.ws + WS_YCAT); bf16_t* ycat = hbuf; bf16_t* projb = (bf16_t*)(p.ws + WS_PROJ);
#ifdef DIAG_MOD
    { const float* md = (const float*)(p.ws + WS_MOD);
      for (size_t i = (size_t)blockIdx.x * 512 + threadIdx.x; i < (size_t)NTOK * DM; i += (size_t)gridDim.x * 512) p.out[i] = i < 61440 ? md[i] : 0.f;
      return; }
#endif
    for (int l = 0; l < 4; ++l) {
        const int j = l >> 1; const bool ab = (l & 1) == 0;
        phase_row(p, l);
#ifdef DIAG_STOP_LAYER
        if (l == DIAG_STOP_LAYER) {
#ifdef DIAG_BITS
            xcd_barrier(bar);
            for (size_t i = (size_t)blockIdx.x * 512 + threadIdx.x; i < (size_t)NTOK * DM; i += (size_t)gridDim.x * 512) { const unsigned u = __float_as_uint(p.out[i]); p.out[i] = (float)((u * 2654435761u) >> 16) * (1.f / 65536.f); }
#endif
#ifdef DIAG_MOD2
            xcd_barrier(bar);
            { const float* md = (const float*)(p.ws + WS_MOD);
              for (size_t i = (size_t)blockIdx.x * 512 + threadIdx.x; i < (size_t)NTOK * DM; i += (size_t)gridDim.x * 512) p.out[i] = i < 61440 ? md[i] : 0.f; }
#endif
            return; }
#endif
        phase_conv(p, l, lds);
        xcd_barrier(bar);
#ifdef DIAG_L
        if (l == DIAG_L && DIAG_S == 0) { unsigned* hb = (unsigned*)hbuf;
            for (size_t i = (size_t)blockIdx.x * 512 + threadIdx.x; i < (size_t)NTOK * DM / 2; i += (size_t)gridDim.x * 512) { const unsigned v = __hip_atomic_load(hb + i, __ATOMIC_RELAXED, __HIP_MEMORY_SCOPE_AGENT);
                p.out[2 * i] = __uint_as_float(v << 16); p.out[2 * i + 1] = __uint_as_float(v & 0xffff0000u); }
            return; }
#endif
        { pg8::StaticOrder S; pg8::Gemm g; g.A = hbuf; g.Bt = (const bf16_t*)(p.ws + WS_WIN); g.M = NTOK; g.K = 1024;
          if (ab) { g.N = 7168; S.init(g.M, g.N, (int)gridDim.x, (int)blockIdx.x); pg8::EpiBf16S E; E.O = projb; E.ldc = 7168; E.stats = nullptr; E.st_lo = 0; E.st_hi = 0;
              pg8::gemm_phase<pg8::EpiBf16S, pg8::StaticOrder, false>(lds, g, S, E, nullptr); }
          else { g.N = 6144; S.init(g.M, g.N, (int)gridDim.x, (int)blockIdx.x); pg8::EpiBf16S E; E.O = projb; E.ldc = 6144; E.stats = (float*)(p.ws + WS_STATS); E.st_lo = 8; E.st_hi = 16;
              pg8::gemm_phase<pg8::EpiBf16S, pg8::StaticOrder, false>(lds, g, S, E, nullptr); } }
        xcd_barrier(bar);
#ifdef DIAG_L
        if (l == DIAG_L && DIAG_S == 1) { diag_dump_bf16(p, projb, ab ? 7 : 6); return; }
#endif
        if (ab) { phase_mix_ab(p, j, lds); xcd_barrier(bar); phase_combine(p, j); }
        else phase_mix_c(p, j, lds);
        xcd_barrier(bar);
#ifdef DIAG_L
        if (l == DIAG_L && DIAG_S == 2) { diag_dump_bf16(p, ycat, 2); return; }
        if (l == DIAG_L && DIAG_S == 4) {
            for (size_t i = (size_t)blockIdx.x * 512 + threadIdx.x; i < (size_t)NTOK * DM; i += (size_t)gridDim.x * 512) { const size_t rr = i >> 10; const float a = (rr >= DIAG_R0 && rr < DIAG_R1) ? bf2f(ycat[rr * 2048 + (i & 1023) + DIAG_HALF * 1024]) : 0.f;
                p.out[i] = (float)((__float_as_uint(a) * 2654435761u) >> 16) * (1.f / 65536.f); }
            return; }
#endif
        { pg8::StaticOrder S; pg8::Gemm g; g.A = ycat; g.Bt = (const bf16_t*)(p.ws + WS_WOUT); g.M = NTOK; g.N = 1024; g.K = 2048; S.init(g.M, g.N, (int)gridDim.x, (int)blockIdx.x);
          pg8::EpiF32 E; E.C = (float*)(p.ws + WS_PROJ); E.ldc = 1024;
          pg8::gemm_phase<pg8::EpiF32, pg8::StaticOrder, false>(lds, g, S, E, nullptr); }
        xcd_barrier(bar);
#ifdef DIAG_L
        if (l == DIAG_L && DIAG_S == 3) { diag_dump_f32(p, (const float*)(p.ws + WS_PROJ)); return; }
#endif
    }
    phase_row(p, 4);
}

extern "C" void kernel_launch(void* const* d_in, const int* in_sizes, int n_in, void* d_out, int out_size, void* d_ws, size_t ws_size, hipStream_t stream) {
    static int grid = 0;
    if (grid == 0) {
        if (n_in != 21 || ws_size < WS_END) { fprintf(stderr, "kernel_launch: unexpected n_in %d / ws_size %zu (need %zu)\n", n_in, ws_size, (size_t)WS_END); grid = -1; return; }
        int dev = 0, cus = 0, per_cu = 0;
        hipGetDevice(&dev); hipDeviceGetAttribute(&cus, hipDeviceAttributeMultiprocessorCount, dev);
        if (hipFuncSetAttribute((const void*)mega_fwd, hipFuncAttributeMaxDynamicSharedMemorySize, LDS_BYTES) != hipSuccess) { fprintf(stderr, "kernel_launch: hipFuncSetAttribute failed\n"); grid = -1; return; }
        hipOccupancyMaxActiveBlocksPerMultiprocessor(&per_cu, (const void*)mega_fwd, 512, LDS_BYTES);
        (void)hipGetLastError();
        if (per_cu < 1) { fprintf(stderr, "kernel_launch: occupancy query says %d blocks per CU\n", per_cu); }
        grid = cus;
    }
    if (grid < 0) return;
    hipMemsetAsync((char*)d_ws + WS_BAR, 0, 16384, stream);
    Params p{};
    p.x_prompt = (const float*)d_in[0]; p.x_sample = (const float*)d_in[1]; p.c = (const float*)d_in[2]; p.state_hgrn = (const float*)d_in[3]; p.c_ctx = (const float*)d_in[4];
    p.w_ada = (const float*)d_in[5]; p.b_ada = (const float*)d_in[6]; p.g_pre = (const float*)d_in[7]; p.g_post = (const float*)d_in[8]; p.w_in_ab = (const float*)d_in[9];
    p.w_out_ab = (const float*)d_in[10]; p.lb_logits = (const float*)d_in[11]; p.g_onorm = (const float*)d_in[12]; p.w_pool = (const float*)d_in[13]; p.pool_scale = (const float*)d_in[14];
    p.w_in_c = (const float*)d_in[15]; p.w_out_c = (const float*)d_in[16]; p.ln_g = (const float*)d_in[17]; p.ln_b = (const float*)d_in[18]; p.w_sp = (const float*)d_in[19]; p.b_sp = (const float*)d_in[20];
    p.out = (float*)d_out; p.ws = (unsigned char*)d_ws;
    void* args[] = {&p};
    hipError_t e = hipLaunchCooperativeKernel((const void*)mega_fwd, dim3(grid), dim3(512), args, LDS_BYTES, stream);
    if (e != hipSuccess) fprintf(stderr, "kernel_launch: cooperative launch failed: %s (grid %d)\n", hipGetErrorString(e), grid);
}
```

```cpp
#include <hip/hip_runtime.h>
#include <hip/hip_cooperative_groups.h>
#include <cstdio>
namespace cg = cooperative_groups;
namespace pg8 {
#define PG8_LAS __attribute__((address_space(3)))
typedef unsigned short bf16_t;
typedef short bf16x8 __attribute__((ext_vector_type(8)));
typedef float f32x4 __attribute__((ext_vector_type(4)));
typedef unsigned u32x4 __attribute__((ext_vector_type(4)));
constexpr int BM = 256, BK = 64, HALF = 128, HTB = HALF * BK * 2  , STAGE_BYTES = 8 * HTB, NXCD = 8, WGM = 8;

__host__ __device__ __forceinline__ int lds_byte(int r, int c) { const int st = (r >> 4) * 2 + (c >> 5), rr = r & 15, cc = c & 31, ob = rr * 64 + cc * 2; return st * 1024 + (ob ^ (((ob >> 9) & 1) << 5)); }
__host__ __device__ __forceinline__ void stage_rc(int b, int& R, int& C) { const int st = b / 1024, sb = b % 1024, swz = sb ^ (((sb >> 9) & 1) << 5); R = (st >> 1) * 16 + swz / 64; C = (st & 1) * 32 + (swz % 64) / 2; }
__host__ __device__ __forceinline__ int perm32(int rho) { const int n = rho >> 4, i = rho & 15; return 8 * (i >> 2) + 4 * n + (i & 3); }

struct Unit { int pm, pn; };
struct Gemm { const bf16_t* A; const bf16_t* Bt; int M, N, K; };

struct StaticOrder {
    int nM, nN, nwg, G, c;
    __host__ __device__ void init(int M, int N, int G_, int c_) { nM = M / BM; nN = N / BM; nwg = nM * nN; G = G_; c = c_; }
    __host__ __device__ bool next(int i, Unit& u) const {
        const long L = (long)i * G + c; if (L >= nwg) return false;
        int wgid = (int)L; { const int q = nwg / NXCD, r = nwg % NXCD, xcd = wgid % NXCD, off = wgid / NXCD; wgid = (xcd < r ? xcd * (q + 1) : r * (q + 1) + (xcd - r) * q) + off; }
        const int nig = WGM * nN, gid = wgid / nig, fm = gid * WGM, gsz = (nM - fm) < WGM ? (nM - fm) : WGM;
        u.pm = fm + ((wgid % nig) % gsz); u.pn = (wgid % nig) / gsz; return true;
    }
    __device__ __forceinline__ void a_ready(const Unit&) const {}
    __device__ __forceinline__ void done(const Unit&) const {}
};
__device__ __forceinline__ unsigned cvt_pk_bf16(float lo, float hi) { unsigned r; asm volatile("v_cvt_pk_bf16_f32 %0, %1, %2\n\ts_nop 1" : "=v"(r) : "v"(lo), "v"(hi)); return r; }
typedef float f32x2 __attribute__((ext_vector_type(2)));
struct EpiF32 {
    static constexpr bool PERM = false, AFTER_DRAIN = false;
    float* C; int ldc;
    __device__ __forceinline__ void operator()(const f32x4 (&acc)[2][2][4][2], const Unit& u, int wr, int wc, int fr, int fq) const {
        const int row0 = u.pm * BM + wr * 64 + fr, col0 = u.pn * BM + wc * 32 + 4 * fq;
#pragma unroll
        for (int ai = 0; ai < 2; ++ai)
#pragma unroll
            for (int m = 0; m < 4; ++m) { float* rowp = C + (size_t)(row0 + ai * HALF + m * 16) * ldc + col0;
#pragma unroll
                for (int bj = 0; bj < 2; ++bj)
#pragma unroll
                    for (int n = 0; n < 2; ++n) *(f32x4*)(rowp + bj * HALF + n * 16) = acc[ai][bj][m][n]; }
    }
};
struct EpiBf16S {
    static constexpr bool PERM = true, AFTER_DRAIN = false;
    bf16_t* O; int ldc; float* stats; int st_lo, st_hi; int sl_hi; const float* lbp; int kg_hi;
    __device__ __forceinline__ void operator()(const f32x4 (&acc)[2][2][4][2], const Unit& u, int wr, int wc, int fr, int fq) const {
        const int row0 = u.pm * BM + wr * 64 + fr; const int col0 = u.pn * BM + wc * 32 + 8 * fq;
        const bool dost = (stats != nullptr) && u.pn >= st_lo && u.pn < st_hi;
        const bool dosl = u.pn < sl_hi; const bool dokg = u.pn >= sl_hi && u.pn < kg_hi;
#pragma unroll
        for (int ai = 0; ai < 2; ++ai)
#pragma unroll
            for (int m = 0; m < 4; ++m) { const int row = row0 + ai * HALF + m * 16; bf16_t* rowp = O + (size_t)row * ldc + col0; float s = 0.f, q = 0.f;
#pragma unroll
                for (int bj = 0; bj < 2; ++bj) { f32x4 v0 = acc[ai][bj][m][0] + 0.f, v1 = acc[ai][bj][m][1] + 0.f;
                    if (dokg) { const float* lq = lbp + (col0 + bj * HALF - 256 * sl_hi); const f32x4 l0 = *(const f32x4*)lq, l1 = *(const f32x4*)(lq + 4);
#pragma unroll
                        for (int q4 = 0; q4 < 4; ++q4) { v0[q4] = (1.f - l0[q4]) * __builtin_amdgcn_rcpf(1.f + __expf(v0[q4])); v1[q4] = (1.f - l1[q4]) * __builtin_amdgcn_rcpf(1.f + __expf(v1[q4])); } }
                    if (dosl) {
#pragma unroll
                        for (int q4 = 0; q4 < 4; ++q4) { v0[q4] = v0[q4] * __builtin_amdgcn_rcpf(1.f + __expf(-v0[q4])); v1[q4] = v1[q4] * __builtin_amdgcn_rcpf(1.f + __expf(-v1[q4])); } }
                    u32x4 w; w.x = cvt_pk_bf16(v0[0], v0[1]); w.y = cvt_pk_bf16(v0[2], v0[3]); w.z = cvt_pk_bf16(v1[0], v1[1]); w.w = cvt_pk_bf16(v1[2], v1[3]);
                    *(u32x4*)(rowp + bj * HALF) = w;
                    s += (v0[0] + v0[1]) + (v0[2] + v0[3]) + (v1[0] + v1[1]) + (v1[2] + v1[3]);
                    q += (v0[0] * v0[0] + v0[1] * v0[1]) + (v0[2] * v0[2] + v0[3] * v0[3]) + (v1[0] * v1[0] + v1[1] * v1[1]) + (v1[2] * v1[2] + v1[3] * v1[3]); }
                if (dost) { s += __shfl_xor(s, 16); s += __shfl_xor(s, 32); q += __shfl_xor(q, 16); q += __shfl_xor(q, 32);
                    if (fq == 0) { float* sp = stats + (((size_t)(u.pn - st_lo) * 12288 + row) * 4 + wc) * 2; sp[0] = s; sp[1] = q; } } }
    }
};
template <class Epi, class Sched, bool STAMP = false>
__device__ __forceinline__ void gemm_phase(PG8_LAS unsigned char* lds, const Gemm g, const Sched& S, const Epi& E, unsigned long long* stamps) {
    int tid_l = threadIdx.x; asm volatile("" : "+v"(tid_l));
    const int tid = tid_l, wid = __builtin_amdgcn_readfirstlane(tid >> 6), lane = tid & 63, wr = wid >> 2, wc = wid & 3, fr = lane & 15, fq = lane >> 4;
    const int K = g.K, nt = K / BK;
    int ts_lo = 0, ts_hi = 0, nts = 0; const unsigned long long rt_entry = STAMP ? (unsigned long long)wall_clock64() : 0ull;
#define PG8_STAMP() do { if (STAMP && wid == 0 && nts < 64) { const unsigned long long _c = (unsigned long long)clock64(); \
        ts_lo = (lane == nts) ? (int)(unsigned)_c : ts_lo; ts_hi = (lane == nts) ? (int)(unsigned)(_c >> 32) : ts_hi; ++nts; } } while (0)
    PG8_STAMP();
    unsigned voffA[2], voffB[2];
#pragma unroll
    for (int i = 0; i < 2; ++i) { int R, C; stage_rc(tid * 16 + i * 8192, R, C); const int Rb = Epi::PERM ? ((R & ~31) + perm32(R & 31)) : R;
        voffA[i] = (unsigned)(R * K + C) * 2u; voffB[i] = (unsigned)(Rb * K + C) * 2u; }
    const size_t kstep = (size_t)(BK * 2);
    const size_t hstep = (size_t)HALF * K * 2;
    const size_t tstep = 2 * hstep;
    const unsigned ldsw = (unsigned)wid * 1024u;
    const int aoff = lds_byte(wr * 64 + fr, fq * 8), boff = lds_byte(wc * 32 + fr, fq * 8);
#define PG8_SA(b, h) (((b) * 2 + (h)) * HTB)
#define PG8_SB(b, h) ((4 + (b) * 2 + (h)) * HTB)
#define PG8_STAGE(bufoff, gbase, voff) do { _Pragma("unroll") for (int _i = 0; _i < 2; ++_i) \
        __builtin_amdgcn_global_load_lds((const unsigned*)((const char*)(gbase) + (voff)[_i]), (PG8_LAS unsigned*)(lds + (bufoff) + ldsw + _i * 8192), 16, 0, 0); } while (0)
#define PG8_LDA(dst, b, h) do { _Pragma("unroll") for (int m = 0; m < 4; ++m) _Pragma("unroll") for (int k = 0; k < 2; ++k) dst[m][k] = *(const PG8_LAS bf16x8*)(lds + PG8_SA(b, h) + aoff + m * 2048 + k * 1024); } while (0)
#define PG8_LDB(dst, b, h) do { _Pragma("unroll") for (int n = 0; n < 2; ++n) _Pragma("unroll") for (int k = 0; k < 2; ++k) dst[n][k] = *(const PG8_LAS bf16x8*)(lds + PG8_SB(b, h) + boff + n * 2048 + k * 1024); } while (0)
#define PG8_MMA(ai, bj, At, Bt) do { __builtin_amdgcn_s_setprio(1); _Pragma("unroll") for (int m = 0; m < 4; ++m) _Pragma("unroll") for (int n = 0; n < 2; ++n) _Pragma("unroll") for (int k = 0; k < 2; ++k) \
        acc[ai][bj][m][n] = __builtin_amdgcn_mfma_f32_16x16x32_bf16(Bt[n][k], At[m][k], acc[ai][bj][m][n], 0, 0, 0); __builtin_amdgcn_s_setprio(0); } while (0)
#define PG8_WAIT_V(n) asm volatile("s_waitcnt vmcnt(" #n ")" ::: "memory")
#define PG8_WAIT_L(n) asm volatile("s_waitcnt lgkmcnt(" #n ")" ::: "memory")
#define PG8_BAR __builtin_amdgcn_s_barrier()
#define PG8_SCHED __builtin_amdgcn_sched_barrier(0)
    Unit cur, nxt; int ui = 0;
    if (!S.next(0, cur)) return;
    f32x4 acc[2][2][4][2];
#pragma unroll
    for (int a = 0; a < 2; ++a)
#pragma unroll
        for (int b = 0; b < 2; ++b)
#pragma unroll
            for (int m = 0; m < 4; ++m)
#pragma unroll
                for (int n = 0; n < 2; ++n) acc[a][b][m][n] = (f32x4){0.f, 0.f, 0.f, 0.f};
    bf16x8 At[4][2], B0[2][2], B1[2][2];
    const char* cA = (const char*)g.A + (size_t)cur.pm * tstep; const char* cB = (const char*)g.Bt + (size_t)cur.pn * tstep;
    S.a_ready(cur);
    PG8_STAGE(PG8_SB(0, 0), cB, voffB); PG8_STAGE(PG8_SA(0, 0), cA, voffA); PG8_STAGE(PG8_SB(0, 1), cB + hstep, voffB); PG8_STAGE(PG8_SA(0, 1), cA + hstep, voffA);
    if (wr == 1) PG8_BAR;
    PG8_WAIT_V(4); PG8_BAR;
    PG8_STAGE(PG8_SB(1, 0), cB + kstep, voffB); PG8_STAGE(PG8_SA(1, 0), cA + kstep, voffA); PG8_STAGE(PG8_SB(1, 1), cB + hstep + kstep, voffB);
    PG8_WAIT_V(6); PG8_BAR;
    PG8_STAMP();
    for (;;) {
        const bool has_next = S.next(ui + 1, nxt);
        const char* nA = has_next ? (const char*)g.A + (size_t)nxt.pm * tstep : cA; const char* nB = has_next ? (const char*)g.Bt + (size_t)nxt.pn * tstep : cB;
        for (int t = 0; t < nt; t += 2) {
            const bool last = (t == nt - 2);
            const char* a1 = cA + (size_t)(t + 1) * kstep;
            const char* a2 = last ? nA : cA + (size_t)(t + 2) * kstep; const char* b2 = last ? nB : cB + (size_t)(t + 2) * kstep;
            const char* a3 = a2 + kstep; const char* b3 = b2 + kstep;
            if (last && has_next) S.a_ready(nxt);
            PG8_LDB(B0, 0, 0); PG8_SCHED; PG8_LDA(At, 0, 0); PG8_STAGE(PG8_SA(1, 1), a1 + hstep, voffA);
            PG8_WAIT_L(8); PG8_BAR; PG8_WAIT_L(0); PG8_MMA(0, 0, At, B0); PG8_BAR; PG8_SCHED;
            PG8_LDB(B1, 0, 1); PG8_STAGE(PG8_SB(0, 0), b2, voffB);
            PG8_BAR; PG8_WAIT_L(0); PG8_MMA(0, 1, At, B1); PG8_BAR;
            PG8_LDA(At, 0, 1); PG8_STAGE(PG8_SA(0, 0), a2, voffA);
            PG8_BAR; PG8_WAIT_L(0); PG8_MMA(1, 0, At, B0); PG8_BAR; PG8_SCHED;
            PG8_STAGE(PG8_SB(0, 1), b2 + hstep, voffB);
            PG8_WAIT_V(6); PG8_BAR; PG8_MMA(1, 1, At, B1); PG8_BAR;
            PG8_LDB(B0, 1, 0); PG8_SCHED; PG8_LDA(At, 1, 0); PG8_STAGE(PG8_SA(0, 1), a2 + hstep, voffA);
            PG8_WAIT_L(8); PG8_BAR; PG8_WAIT_L(0); PG8_MMA(0, 0, At, B0); PG8_BAR; PG8_SCHED;
            PG8_LDB(B1, 1, 1); PG8_STAGE(PG8_SB(1, 0), b3, voffB);
            PG8_BAR; PG8_WAIT_L(0); PG8_MMA(0, 1, At, B1); PG8_BAR;
            PG8_LDA(At, 1, 1); PG8_STAGE(PG8_SA(1, 0), a3, voffA);
            PG8_BAR; PG8_WAIT_L(0); PG8_MMA(1, 0, At, B0); PG8_BAR; PG8_SCHED;
            PG8_STAGE(PG8_SB(1, 1), b3 + hstep, voffB);
            PG8_WAIT_V(6); PG8_BAR; PG8_MMA(1, 1, At, B1); PG8_BAR;
        }
        PG8_STAMP();
        if constexpr (!Epi::AFTER_DRAIN) { E(acc, cur, wr, wc, fr, fq); S.done(cur); }
        PG8_STAMP();
        if (!has_next) break;
#pragma unroll
        for (int a = 0; a < 2; ++a)
#pragma unroll
            for (int b = 0; b < 2; ++b)
#pragma unroll
                for (int m = 0; m < 4; ++m)
#pragma unroll
                    for (int n = 0; n < 2; ++n) acc[a][b][m][n] = (f32x4){0.f, 0.f, 0.f, 0.f};
        cur = nxt; cA = nA; cB = nB; ++ui;
    }
    PG8_WAIT_V(0);
    if (wr == 0) PG8_BAR;
    PG8_BAR;
    if constexpr (Epi::AFTER_DRAIN) { E.fused(acc, cur, wr, wc, fr, fq, lds, wid, lane); S.done(cur); }
    PG8_STAMP();
    if (STAMP && wid == 0) { stamps[lane] = lane < nts ? (((unsigned long long)(unsigned)ts_hi << 32) | (unsigned)ts_lo) : 0ull;
        if (lane == 62) stamps[62] = rt_entry; if (lane == 63) stamps[63] = (unsigned long long)wall_clock64(); }
#undef PG8_STAMP
#undef PG8_SA
#undef PG8_SB
#undef PG8_STAGE
#undef PG8_LDA
#undef PG8_LDB
#undef PG8_MMA
#undef PG8_WAIT_V
#undef PG8_WAIT_L
#undef PG8_BAR
#undef PG8_SCHED
}
}

#define LAS __attribute__((address_space(3)))
using pg8::bf16_t; using pg8::bf16x8; using pg8::f32x4; using pg8::u32x4;
typedef short bf16x4 __attribute__((ext_vector_type(4)));
typedef unsigned u32x2 __attribute__((ext_vector_type(2)));
typedef float f32x2v __attribute__((ext_vector_type(2)));
constexpr int NTOK = 12288, NPROMPT = 4096, DM = 1024;
constexpr int LDS_BYTES = 147456;
constexpr float EPSV = 1e-6f;
constexpr size_t WS_PROJ = 0;
constexpr size_t WS_YCAT = 176160768;
constexpr size_t WS_WIN  = WS_YCAT + 50331648;
constexpr size_t WS_WOUT = WS_WIN + 14680064;
constexpr size_t WS_STATS = WS_WOUT + 4194304;
constexpr size_t WS_MOD = WS_STATS + 3145728;
constexpr size_t WS_LB = WS_MOD + 245760;
constexpr size_t WS_BAR = WS_LB + 16384;
constexpr size_t WS_WIN2 = WS_BAR + 16384;
constexpr size_t WS_WOUT2 = WS_WIN2 + 14680064;
constexpr size_t WS_END = WS_WOUT2 + 4194304;
__device__ __forceinline__ size_t ws_win(int l) { return (l & 1) ? WS_WIN2 : WS_WIN; }
__device__ __forceinline__ size_t ws_wout(int l) { return (l & 1) ? WS_WOUT2 : WS_WOUT; }

struct Params {
    const float *x_prompt, *x_sample, *c, *state_hgrn, *c_ctx, *w_ada, *b_ada, *g_pre, *g_post, *w_in_ab, *w_out_ab, *lb_logits, *g_onorm, *w_pool, *pool_scale,
        *w_in_c, *w_out_c, *ln_g, *ln_b, *w_sp, *b_sp;
    float* out; unsigned char* ws;
};

__device__ __forceinline__ float bf2f(bf16_t b) { return __uint_as_float(((unsigned)b) << 16); }
__device__ __forceinline__ bf16_t f2bf(float f) { unsigned u = __float_as_uint(f); u += 0x7FFFu + ((u >> 16) & 1u); return (bf16_t)(u >> 16); }
__device__ __forceinline__ float silu_f(float x) { return x * __builtin_amdgcn_rcpf(1.f + __expf(-x)); }
__device__ __forceinline__ float wave_sum(float v) { v += __shfl_xor(v, 1); v += __shfl_xor(v, 2); v += __shfl_xor(v, 4); v += __shfl_xor(v, 8); v += __shfl_xor(v, 16); v += __shfl_xor(v, 32); return v; }

#define XB_TMO      128
#define XB_XCNT(j)  (256  + 64 * (j))
#define XB_XSUB(j)  (1280 + 64 * (j))
#define XB_XGEN(j)  (2304 + 64 * (j))
#define XB_TOP      3328
#define XB_TOPGEN   3392
#define XCD_BAR_WORDS 3456
#define XB_SPIN_CAP (1u << 20)
__device__ __forceinline__ unsigned xb_ld(unsigned* p)              { return __hip_atomic_load(p, __ATOMIC_RELAXED, __HIP_MEMORY_SCOPE_AGENT); }
__device__ __forceinline__ unsigned xb_add(unsigned* p, unsigned v) { return __hip_atomic_fetch_add(p, v, __ATOMIC_RELAXED, __HIP_MEMORY_SCOPE_AGENT); }
__device__ __forceinline__ unsigned xb_xcc_id() { return (unsigned)__builtin_amdgcn_s_getreg((3 << 11) | 20) & 0xFu; }
#define XB_SPIN(cond, bar) do { unsigned _sp = 0; while (cond) { __builtin_amdgcn_s_sleep(1); \
    if ((++_sp & 255u) == 0u) { if (xb_ld(&(bar)[XB_TMO])) break; if (_sp > XB_SPIN_CAP) { atomicAdd(&(bar)[XB_TMO], 1u); break; } } } } while (0)
struct XcdBarrier { unsigned* bar; unsigned x; volatile LAS unsigned* st; };
__device__ __forceinline__ XcdBarrier xcd_barrier_post(unsigned* bar, volatile LAS unsigned* st) {
    XcdBarrier b; b.bar = bar; b.x = xb_xcc_id(); b.st = st;
    if (threadIdx.x == 0) (void)xb_add(&bar[XB_XCNT(b.x)], 1u);
    return b;
}
__device__ __forceinline__ void xcd_barrier_complete(unsigned* bar, unsigned x, unsigned& nloc, unsigned& nx) {
    const unsigned G = gridDim.x * gridDim.y * gridDim.z;
    unsigned sum, cnt, mine, sp = 0u;
    for (;;) {
        sum = 0u; cnt = 0u; mine = 0u;
#pragma unroll
        for (unsigned j = 0; j < 16; ++j) { const unsigned c = xb_ld(&bar[XB_XCNT(j)]); sum += c; cnt += (c > 0u) ? 1u : 0u; mine = (j == x) ? c : mine; }
        if (sum == G) break;
        __builtin_amdgcn_s_sleep(1);
        if ((++sp & 255u) == 0u) { if (xb_ld(&bar[XB_TMO])) break; if (sp > XB_SPIN_CAP) { atomicAdd(&bar[XB_TMO], 1u); break; } }
    }
    nloc = mine > 0u ? mine : 1u; nx = cnt > 0u ? cnt : 1u;
}
__device__ __forceinline__ void xcd_barrier(const XcdBarrier& b) {
    asm volatile("s_waitcnt vmcnt(0)" ::: "memory");
    __syncthreads();
    if (threadIdx.x == 0) {
        unsigned* bar = b.bar;
        __builtin_amdgcn_s_waitcnt(0);
        unsigned nloc = b.st[0], nx = b.st[1];
        if (nloc == 0u) { xcd_barrier_complete(bar, b.x, nloc, nx); b.st[0] = nloc; b.st[1] = nx; }
        const unsigned old = xb_add(&bar[XB_XSUB(b.x)], 1u);
        const unsigned gen = old / nloc;
        if (old + 1u == (gen + 1u) * nloc) {
            __builtin_amdgcn_fence(__ATOMIC_RELEASE, "agent");
            asm volatile("s_waitcnt vmcnt(0)" ::: "memory");
            const unsigned og = xb_add(&bar[XB_TOP], 1u);
            const unsigned tg = og / nx;
            if (og + 1u == (tg + 1u) * nx) xb_add(&bar[XB_TOPGEN], 1u);
            else XB_SPIN(xb_ld(&bar[XB_TOPGEN]) == tg, bar);
            __builtin_amdgcn_fence(__ATOMIC_ACQUIRE, "agent");
            xb_add(&bar[XB_XGEN(b.x)], 1u);
            asm volatile("s_waitcnt vmcnt(0)" ::: "memory");
        } else {
            XB_SPIN(xb_ld(&bar[XB_XGEN(b.x)]) == gen, bar);
            __builtin_amdgcn_fence(__ATOMIC_ACQUIRE, "agent");
            asm volatile("s_waitcnt vmcnt(0)" ::: "memory");
        }
    }
    __syncthreads();
}

__device__ __forceinline__ void phase_mod(const Params& p, LAS unsigned char* lds) {
    int tid_l = threadIdx.x; asm volatile("" : "+v"(tid_l)); const int tid = tid_l;
    LAS float* sc = (LAS float*)lds;
    LAS float* red = sc + 5 * 1024;
    for (int i = tid; i < 5 * 1024; i += 512) { const int n = i >> 10, k = i & 1023; const float v = (n == 0) ? p.c_ctx[k] : p.c[(n - 1) * 1024 + k]; sc[i] = silu_f(v); }
    __syncthreads();
    float* mod = (float*)(p.ws + WS_MOD);
    for (int unit = blockIdx.x; unit < 192; unit += gridDim.x) {
        const int l = unit / 48, c0 = (unit % 48) * 64, cc = tid & 63, ks = tid >> 6;
        const float* w = p.w_ada + (size_t)l * 1024 * 3072 + c0 + cc;
        float a0 = 0.f, a1 = 0.f, a2 = 0.f, a3 = 0.f, a4 = 0.f;
#pragma unroll 8
        for (int k = ks * 128; k < ks * 128 + 128; ++k) { const float wv = w[(size_t)k * 3072];
            a0 += sc[k] * wv; a1 += sc[1024 + k] * wv; a2 += sc[2048 + k] * wv; a3 += sc[3072 + k] * wv; a4 += sc[4096 + k] * wv; }
        LAS float* r = red + (ks * 64 + cc) * 5; r[0] = a0; r[1] = a1; r[2] = a2; r[3] = a3; r[4] = a4;
        __syncthreads();
        if (tid < 320) { const int c2 = tid & 63, n = tid >> 6; float s = 0.f;
#pragma unroll
            for (int k8 = 0; k8 < 8; ++k8) s += red[(k8 * 64 + c2) * 5 + n];
            mod[(size_t)(l * 5 + n) * 3072 + c0 + c2] = s + p.b_ada[l * 3072 + c0 + c2]; }
        __syncthreads();
    }
    float* LB = (float*)(p.ws + WS_LB);
    for (int i = blockIdx.x * 512 + tid; i < 2048; i += gridDim.x * 512) { const float l0 = p.lb_logits[i], l1 = p.lb_logits[2048 + i];
        LB[i] = 0.f; LB[2048 + i] = 1.f / (1.f + __expf(l0 - l1)); }
}

__device__ __forceinline__ void phase_row(const Params& p, int l) {
    int tid_l = threadIdx.x; asm volatile("" : "+v"(tid_l)); const int tid = tid_l, lane = tid & 63, wv = tid >> 6;
    const float* mod = (const float*)(p.ws + WS_MOD);
    const bf16_t* ybuf = (const bf16_t*)(p.ws + WS_PROJ);
    bf16_t* hbuf = (bf16_t*)(p.ws + WS_YCAT);
    const int rstep = gridDim.x * 8;
    for (int row0 = blockIdx.x * 8 + wv; row0 < NTOK; row0 += 2 * rstep) {
        int rows[2]; rows[0] = row0; rows[1] = (row0 + rstep < NTOK) ? row0 + rstep : row0;
        int nn[2]; f32x4 x[2][4], y[2][4];
#pragma unroll
        for (int q = 0; q < 2; ++q) { const int row = rows[q]; nn[q] = row < NPROMPT ? 0 : 1 + ((row - NPROMPT) >> 11);
            const float* xsrc = (l == 0) ? (row < NPROMPT ? p.x_prompt + (size_t)row * DM : p.x_sample + (size_t)(row - NPROMPT) * DM) : p.out + (size_t)row * DM;
#pragma unroll
            for (int i = 0; i < 4; ++i) x[q][i] = *(const f32x4*)(xsrc + (i * 64 + lane) * 4);
            if (l > 0) {
#pragma unroll
                for (int i = 0; i < 4; ++i) { const u32x2 yv = *(const u32x2*)(ybuf + (size_t)row * DM + (i * 64 + lane) * 4);
                    y[q][i] = (f32x4){__uint_as_float(yv.x << 16), __uint_as_float(yv.x & 0xffff0000u), __uint_as_float(yv.y << 16), __uint_as_float(yv.y & 0xffff0000u)}; } } }
        if (l > 0) {
            float ss[2];
#pragma unroll
            for (int q = 0; q < 2; ++q) { ss[q] = 0.f;
#pragma unroll
                for (int i = 0; i < 4; ++i) ss[q] += y[q][i][0] * y[q][i][0] + y[q][i][1] * y[q][i][1] + y[q][i][2] * y[q][i][2] + y[q][i][3] * y[q][i][3]; }
            ss[0] = wave_sum(ss[0]); ss[1] = wave_sum(ss[1]);
            const float* gp = p.g_post + (l - 1) * 1024;
#pragma unroll
            for (int q = 0; q < 2; ++q) { const float r = rsqrtf(ss[q] * (1.f / 1024.f) + EPSV); const float* gt = mod + (size_t)((l - 1) * 5 + nn[q]) * 3072 + 2048;
#pragma unroll
                for (int i = 0; i < 4; ++i) { const int col = (i * 64 + lane) * 4; const f32x4 g = *(const f32x4*)(gt + col), qq = *(const f32x4*)(gp + col); x[q][i] = x[q][i] + g * (y[q][i] * r * qq); } }
        }
#pragma unroll
        for (int q = 0; q < 2; ++q)
#pragma unroll
            for (int i = 0; i < 4; ++i) *(f32x4*)(p.out + (size_t)rows[q] * DM + (i * 64 + lane) * 4) = x[q][i];
        if (l < 4) {
            float ss[2];
#pragma unroll
            for (int q = 0; q < 2; ++q) { ss[q] = 0.f;
#pragma unroll
                for (int i = 0; i < 4; ++i) ss[q] += x[q][i][0] * x[q][i][0] + x[q][i][1] * x[q][i][1] + x[q][i][2] * x[q][i][2] + x[q][i][3] * x[q][i][3]; }
            ss[0] = wave_sum(ss[0]); ss[1] = wave_sum(ss[1]);
            const float* gp = p.g_pre + l * 1024;
#pragma unroll
            for (int q = 0; q < 2; ++q) { const float r = rsqrtf(ss[q] * (1.f / 1024.f) + EPSV); const float* sh = mod + (size_t)(l * 5 + nn[q]) * 3072; const float* scl = sh + 1024;
#pragma unroll
                for (int i = 0; i < 4; ++i) { const int col = (i * 64 + lane) * 4; const f32x4 a = *(const f32x4*)(sh + col), sv = *(const f32x4*)(scl + col), g = *(const f32x4*)(gp + col);
                    const f32x4 hv = x[q][i] * r * g * (sv + 1.f) + a; u32x2 w; w.x = pg8::cvt_pk_bf16(hv[0], hv[1]); w.y = pg8::cvt_pk_bf16(hv[2], hv[3]);
                    *(u32x2*)(hbuf + (size_t)rows[q] * DM + col) = w; } }
        }
    }
}

__device__ __forceinline__ void conv_tile(const float* W, int K, int N, bf16_t* Wt, int kt, int nt, LAS unsigned char* lds) {
    int tid_l = threadIdx.x; asm volatile("" : "+v"(tid_l)); const int tid = tid_l; LAS float* tile = (LAS float*)lds;
    const int k0 = kt * 64, n0 = nt * 64;
#pragma unroll
    for (int it = 0; it < 2; ++it) { const int r = it * 32 + (tid >> 4), c4 = (tid & 15) * 4; const f32x4 v = *(const f32x4*)(W + (size_t)(k0 + r) * N + n0 + c4);
        tile[r * 65 + c4] = v[0]; tile[r * 65 + c4 + 1] = v[1]; tile[r * 65 + c4 + 2] = v[2]; tile[r * 65 + c4 + 3] = v[3]; }
    __syncthreads();
    { const int nn = tid >> 3, k8 = (tid & 7) * 8; u32x4 w;
      w.x = pg8::cvt_pk_bf16(tile[(k8 + 0) * 65 + nn], tile[(k8 + 1) * 65 + nn]); w.y = pg8::cvt_pk_bf16(tile[(k8 + 2) * 65 + nn], tile[(k8 + 3) * 65 + nn]);
      w.z = pg8::cvt_pk_bf16(tile[(k8 + 4) * 65 + nn], tile[(k8 + 5) * 65 + nn]); w.w = pg8::cvt_pk_bf16(tile[(k8 + 6) * 65 + nn], tile[(k8 + 7) * 65 + nn]);
      *(u32x4*)(Wt + (size_t)(n0 + nn) * K + k0 + k8) = w; }
    __syncthreads();
}
__device__ __forceinline__ void fold_unit(const Params& p, int j, int fu, LAS unsigned char* lds, bf16_t* Wt) {
    int tid_l = threadIdx.x; asm volatile("" : "+v"(tid_l)); const int tid = tid_l; const int g = fu >> 5, et = (fu >> 3) & 3, kt = fu & 7; const int e0 = et * 64, k0 = kt * 128;
    LAS float* As = (LAS float*)lds;
    LAS float* Bs = As + 32 * 64;
    const float* wp = p.w_pool + (size_t)(j * 4 + g) * 65536; const float* wi = p.w_in_ab + (size_t)j * 1024 * 7168 + 5120 + g * 256;
    const int e4 = (tid & 15) * 4, k4 = (tid >> 4) * 4;
    float acc[4][4];
#pragma unroll
    for (int i = 0; i < 4; ++i)
#pragma unroll
        for (int q = 0; q < 4; ++q) acc[i][q] = 0.f;
    for (int c0 = 0; c0 < 256; c0 += 32) {
        { const int r = tid >> 4, c4 = (tid & 15) * 4; const f32x4 v = *(const f32x4*)(wp + (size_t)(c0 + r) * 256 + e0 + c4); *(LAS f32x4*)(As + r * 64 + c4) = v; }
        { const int kk = tid >> 2, cc = (tid & 3) * 8; const float* src = wi + (size_t)(k0 + kk) * 7168 + c0 + cc; const f32x4 v0 = *(const f32x4*)src, v1 = *(const f32x4*)(src + 4);
          LAS float* d = Bs + kk * 33 + cc; d[0] = v0[0]; d[1] = v0[1]; d[2] = v0[2]; d[3] = v0[3]; d[4] = v1[0]; d[5] = v1[1]; d[6] = v1[2]; d[7] = v1[3]; }
        __syncthreads();
#pragma unroll 8
        for (int c = 0; c < 32; ++c) { const f32x4 a = *(LAS f32x4*)(As + c * 64 + e4);
#pragma unroll
            for (int i = 0; i < 4; ++i) { const float bv = Bs[(k4 + i) * 33 + c]; acc[i][0] += bv * a[0]; acc[i][1] += bv * a[1]; acc[i][2] += bv * a[2]; acc[i][3] += bv * a[3]; } }
        __syncthreads();
    }
#pragma unroll
    for (int q = 0; q < 4; ++q) { const int e = g * 256 + e0 + e4 + q; const float ps = p.pool_scale[j * 1024 + e];
        u32x2 w; w.x = pg8::cvt_pk_bf16(acc[0][q] * ps, acc[1][q] * ps); w.y = pg8::cvt_pk_bf16(acc[2][q] * ps, acc[3][q] * ps);
        *(u32x2*)(Wt + (size_t)(5120 + e) * 1024 + k0 + k4) = w; }
}
__device__ __forceinline__ void conv_tile2(const float* W0, int K0, int N0, bf16_t* Wt0, int kt0, int nt0, const float* W1, int K1, int N1, bf16_t* Wt1, int kt1, int nt1, LAS unsigned char* lds) {
    int tid_l = threadIdx.x; asm volatile("" : "+v"(tid_l)); const int tid = tid_l; LAS float* tileA = (LAS float*)lds; LAS float* tileB = tileA + 64 * 65;
    f32x4 va[2], vb[2];
#pragma unroll
    for (int it = 0; it < 2; ++it) { const int r = it * 32 + (tid >> 4), c4 = (tid & 15) * 4;
        va[it] = *(const f32x4*)(W0 + (size_t)(kt0 * 64 + r) * N0 + nt0 * 64 + c4); vb[it] = *(const f32x4*)(W1 + (size_t)(kt1 * 64 + r) * N1 + nt1 * 64 + c4); }
#pragma unroll
    for (int it = 0; it < 2; ++it) { const int r = it * 32 + (tid >> 4), c4 = (tid & 15) * 4;
        tileA[r * 65 + c4] = va[it][0]; tileA[r * 65 + c4 + 1] = va[it][1]; tileA[r * 65 + c4 + 2] = va[it][2]; tileA[r * 65 + c4 + 3] = va[it][3];
        tileB[r * 65 + c4] = vb[it][0]; tileB[r * 65 + c4 + 1] = vb[it][1]; tileB[r * 65 + c4 + 2] = vb[it][2]; tileB[r * 65 + c4 + 3] = vb[it][3]; }
    __syncthreads();
    { const int nn = tid >> 3, k8 = (tid & 7) * 8; u32x4 w;
      w.x = pg8::cvt_pk_bf16(tileA[(k8 + 0) * 65 + nn], tileA[(k8 + 1) * 65 + nn]); w.y = pg8::cvt_pk_bf16(tileA[(k8 + 2) * 65 + nn], tileA[(k8 + 3) * 65 + nn]);
      w.z = pg8::cvt_pk_bf16(tileA[(k8 + 4) * 65 + nn], tileA[(k8 + 5) * 65 + nn]); w.w = pg8::cvt_pk_bf16(tileA[(k8 + 6) * 65 + nn], tileA[(k8 + 7) * 65 + nn]);
      *(u32x4*)(Wt0 + (size_t)(nt0 * 64 + nn) * K0 + kt0 * 64 + k8) = w;
      w.x = pg8::cvt_pk_bf16(tileB[(k8 + 0) * 65 + nn], tileB[(k8 + 1) * 65 + nn]); w.y = pg8::cvt_pk_bf16(tileB[(k8 + 2) * 65 + nn], tileB[(k8 + 3) * 65 + nn]);
      w.z = pg8::cvt_pk_bf16(tileB[(k8 + 4) * 65 + nn], tileB[(k8 + 5) * 65 + nn]); w.w = pg8::cvt_pk_bf16(tileB[(k8 + 6) * 65 + nn], tileB[(k8 + 7) * 65 + nn]);
      *(u32x4*)(Wt1 + (size_t)(nt1 * 64 + nn) * K1 + kt1 * 64 + k8) = w; }
    __syncthreads();
}
__device__ __forceinline__ void phase_conv(const Params& p, int l, LAS unsigned char* lds, int mode, int wid, int nw) {
    const int j = l >> 1; const bool ab = (l & 1) == 0;
    const float* Win = ab ? p.w_in_ab + (size_t)j * 1024 * 7168 : p.w_in_c + (size_t)j * 1024 * 6144; const int Nin = ab ? 7168 : 6144;
    const float* Wout = ab ? p.w_out_ab + (size_t)j * 2048 * 1024 : p.w_out_c + (size_t)j * 2048 * 1024;
    bf16_t* WtIn = (bf16_t*)(p.ws + ws_win(l)); bf16_t* WtOut = (bf16_t*)(p.ws + ws_wout(l));
    const int n_in = (mode == 2) ? 0 : 1536, n_out = (mode == 1) ? 0 : 512, n_fold = (ab && mode != 2) ? 128 : 0, n_t = n_in + n_out;
    for (int u = wid; u < n_t; u += 2 * nw) {
        const float* W0; int K0, N0, kt0, nt0; bf16_t* T0;
        if (u < n_in) { nt0 = u >> 4; kt0 = u & 15; if (ab && nt0 >= 80) nt0 += 16; W0 = Win; K0 = 1024; N0 = Nin; T0 = WtIn; } else { const int v = u - n_in; kt0 = v & 31; nt0 = v >> 5; W0 = Wout; K0 = 2048; N0 = 1024; T0 = WtOut; }
        const int u1 = u + nw;
        if (u1 < n_t) { const float* W1; int K1, N1, kt1, nt1; bf16_t* T1;
            if (u1 < n_in) { nt1 = u1 >> 4; kt1 = u1 & 15; if (ab && nt1 >= 80) nt1 += 16; W1 = Win; K1 = 1024; N1 = Nin; T1 = WtIn; } else { const int v = u1 - n_in; kt1 = v & 31; nt1 = v >> 5; W1 = Wout; K1 = 2048; N1 = 1024; T1 = WtOut; }
            conv_tile2(W0, K0, N0, T0, kt0, nt0, W1, K1, N1, T1, kt1, nt1, lds); }
        else conv_tile(W0, K0, N0, T0, kt0, nt0, lds);
    }
    for (int u = wid; u < n_fold; u += nw) fold_unit(p, j, u, lds, WtIn);
}

constexpr int HG_QS = 0, HG_KS = 8704, HG_KT = 17408, HG_VT = 27648, HG_FAC = 37888, HG_BUF = 39424, HG_TOT = 2 * HG_BUF, HG_PT = HG_TOT + 2048;
__device__ __forceinline__ float clampe(float v) { return fminf(fmaxf(v, -80.f), 80.f); }
__device__ __forceinline__ void hgrn_unit(const Params& p, LAS unsigned char* lds, int j, bool sample, int b, int h, int dir) {
    int tid_l = threadIdx.x; asm volatile("" : "+v"(tid_l)); const int tid = tid_l, lane = tid & 63, w = tid >> 6, fr = lane & 15, hq = lane >> 4;
    const int T = sample ? 2048 : 256, nch = T >> 5;
    const size_t rowbase = sample ? (size_t)NPROMPT + (size_t)b * 2048 : (size_t)b * 256;
    bf16_t* proj = (bf16_t*)(p.ws + WS_PROJ);
    const int d = tid & 127, tq = tid >> 7;
    const float lbv = ((const float*)(p.ws + WS_LB))[(j * 2 + dir) * 1024 + h * 128 + d], oml = 1.f - lbv;
    f32x4 S[8];
    if (sample) { const float* s0 = p.state_hgrn + ((((size_t)b * 2 + j) * 2 + dir) * 8 + h) * 16384;
#pragma unroll
        for (int dt = 0; dt < 8; ++dt)
#pragma unroll
            for (int r = 0; r < 4; ++r) S[dt][r] = s0[(16 * dt + 4 * hq + r) * 128 + 16 * w + fr];
    } else {
#pragma unroll
        for (int dt = 0; dt < 8; ++dt) S[dt] = (f32x4){0.f, 0.f, 0.f, 0.f};
    }
    LAS float* TOT = (LAS float*)(lds + HG_TOT);
    bf16_t nq[8], nf[8], nv[8];
    const size_t cq = (size_t)h * 128 + d, cf = 1024 * (1 + dir) + (size_t)h * 128 + d, cv = 3072 + (size_t)h * 128 + d;
    const long rstride = dir ? -7168 : 7168;
#define HG_LOAD(c) do { const int pi0 = (c) * 32 + 8 * tq; const bf16_t* rp = proj + (rowbase + (dir ? (T - 1 - pi0) : pi0)) * 7168; \
        _Pragma("unroll") for (int i = 0; i < 8; ++i) { nq[i] = rp[cq]; nf[i] = rp[cf]; nv[i] = rp[cv]; rp += rstride; } } while (0)
    HG_LOAD(0);
    for (int c = 0; c < nch; ++c) {
        LAS unsigned char* buf = lds + (c & 1) * HG_BUF;
        LAS bf16_t* QS = (LAS bf16_t*)(buf + HG_QS); LAS bf16_t* KS = (LAS bf16_t*)(buf + HG_KS); LAS bf16_t* KT = (LAS bf16_t*)(buf + HG_KT); LAS bf16_t* VT = (LAS bf16_t*)(buf + HG_VT);
        LAS float* FAC = (LAS float*)(buf + HG_FAC);
        float Pc[8], kk[8], qs[8]; float pr = 1.f;
#pragma unroll
        for (int i = 0; i < 8; ++i) { const float k = bf2f(nf[i]); kk[i] = k; pr *= fmaxf(1.f - k, 1e-3f); Pc[i] = pr;     qs[i] = bf2f(nq[i]); }
        const float cs = __logf(pr);
        TOT[tq * 128 + d] = cs;
        __syncthreads();
        const float t0 = TOT[d], t1 = TOT[128 + d], t2 = TOT[256 + d], t3 = TOT[384 + d];
        const float off = (tq > 0 ? t0 : 0.f) + (tq > 1 ? t1 : 0.f) + (tq > 2 ? t2 : 0.f);
        const float R = t0 + t1, Bl = R + t2 + t3;
        bf16_t kbs[8];
        const float ebase = __expf(clampe(off - R));
#pragma unroll
        for (int i = 0; i < 8; ++i) { const int tl = 8 * tq + i;
            const float eq = fminf(fmaxf(ebase * Pc[i], 1e-30f), 1e30f), ek = __builtin_amdgcn_rcpf(eq);
            const unsigned qk = pg8::cvt_pk_bf16(qs[i] * eq, kk[i] * ek); const bf16_t qb = (bf16_t)(qk & 0xffffu), kb = (bf16_t)(qk >> 16);
            QS[tl * 136 + d] = qb; KS[tl * 136 + d] = kb; kbs[i] = kb; }
        { u32x4 kw, vw; kw.x = (unsigned)kbs[0] | ((unsigned)kbs[1] << 16); kw.y = (unsigned)kbs[2] | ((unsigned)kbs[3] << 16); kw.z = (unsigned)kbs[4] | ((unsigned)kbs[5] << 16); kw.w = (unsigned)kbs[6] | ((unsigned)kbs[7] << 16);
          vw.x = (unsigned)nv[0] | ((unsigned)nv[1] << 16); vw.y = (unsigned)nv[2] | ((unsigned)nv[3] << 16); vw.z = (unsigned)nv[4] | ((unsigned)nv[5] << 16); vw.w = (unsigned)nv[6] | ((unsigned)nv[7] << 16);
          *(LAS u32x4*)(KT + d * 40 + 8 * tq) = kw; *(LAS u32x4*)(VT + d * 40 + 8 * tq) = vw; }
        if (tq == 0) { FAC[d] = __expf(R); FAC[128 + d] = __expf(Bl); FAC[256 + d] = __expf(Bl - R); }
        if (c + 1 < nch) HG_LOAD(c + 1);
        __syncthreads();
        LAS bf16_t* PT = (LAS bf16_t*)(lds + HG_PT);
        const int wu = __builtin_amdgcn_readfirstlane(w);
        if (wu < 3) { const int sb = (wu == 2) ? 1 : 0, tb = (wu >= 1) ? 1 : 0;
            f32x4 sc = {0.f, 0.f, 0.f, 0.f};
#pragma unroll
            for (int ks = 0; ks < 4; ++ks) {
                const bf16x8 a = *(LAS bf16x8*)(KS + (16 * sb + fr) * 136 + ks * 32 + hq * 8), bq = *(LAS bf16x8*)(QS + (16 * tb + fr) * 136 + ks * 32 + hq * 8);
                sc = __builtin_amdgcn_mfma_f32_16x16x32_bf16(a, bq, sc, 0, 0, 0); }
            if (wu != 1) {
#pragma unroll
                for (int r = 0; r < 4; ++r) sc[r] = (fr >= 4 * hq + r) ? sc[r] : 0.f; }
            else {
#pragma unroll
                for (int r = 0; r < 4; ++r) sc[r] = sc[r] + 0.f; }
            u32x2 pk; pk.x = pg8::cvt_pk_bf16(sc[0], sc[1]); pk.y = pg8::cvt_pk_bf16(sc[2], sc[3]);
            *(LAS u32x2*)(PT + (tb * 16 + fr) * 40 + 16 * sb + 4 * hq) = pk;
        } else if (wu == 3) { u32x2 z; z.x = 0u; z.y = 0u; *(LAS u32x2*)(PT + fr * 40 + 16 + 4 * hq) = z; }
        const LAS bf16_t* vrow = VT + (16 * w + fr) * 40;
        f32x4 o0 = {0.f, 0.f, 0.f, 0.f}, o1 = o0;
#pragma unroll
        for (int ks = 0; ks < 4; ++ks) {
            const f32x4 e0 = *(LAS f32x4*)(FAC + 32 * ks + 4 * hq), e1 = *(LAS f32x4*)(FAC + 32 * ks + 16 + 4 * hq);
            const f32x4 x0 = S[2 * ks] * e0, x1 = S[2 * ks + 1] * e1;
            u32x4 sb; sb.x = pg8::cvt_pk_bf16(x0[0], x0[1]); sb.y = pg8::cvt_pk_bf16(x0[2], x0[3]); sb.z = pg8::cvt_pk_bf16(x1[0], x1[1]); sb.w = pg8::cvt_pk_bf16(x1[2], x1[3]);
            const LAS bf16_t* q0 = QS + fr * 136 + 32 * ks + 4 * hq; const LAS bf16_t* q1 = q0 + 16 * 136;
            u32x4 qa0, qa1; { const u32x2 lo = *(const LAS u32x2*)q0, hi = *(const LAS u32x2*)(q0 + 16); qa0.x = lo.x; qa0.y = lo.y; qa0.z = hi.x; qa0.w = hi.y; }
            { const u32x2 lo = *(const LAS u32x2*)q1, hi = *(const LAS u32x2*)(q1 + 16); qa1.x = lo.x; qa1.y = lo.y; qa1.z = hi.x; qa1.w = hi.y; }
            o0 = __builtin_amdgcn_mfma_f32_16x16x32_bf16(__builtin_bit_cast(bf16x8, qa0), __builtin_bit_cast(bf16x8, sb), o0, 0, 0, 0);
            o1 = __builtin_amdgcn_mfma_f32_16x16x32_bf16(__builtin_bit_cast(bf16x8, qa1), __builtin_bit_cast(bf16x8, sb), o1, 0, 0, 0);
        }
        { const bf16x8 vb8 = *(const LAS bf16x8*)(vrow + 8 * hq);
#pragma unroll
          for (int dt = 0; dt < 8; ++dt) {
              const bf16x8 ka = *(const LAS bf16x8*)(KT + (16 * dt + fr) * 40 + 8 * hq);
              f32x4 t = {0.f, 0.f, 0.f, 0.f};
              t = __builtin_amdgcn_mfma_f32_16x16x32_bf16(ka, vb8, t, 0, 0, 0);
              const f32x4 el = *(LAS f32x4*)(FAC + 128 + 16 * dt + 4 * hq), er = *(LAS f32x4*)(FAC + 256 + 16 * dt + 4 * hq);
              S[dt] = S[dt] * el + er * t;
          } }
        __syncthreads();
        { u32x4 pa0, pa1, vb;
          { const LAS bf16_t* p0 = PT + fr * 40 + 4 * hq; const u32x2 lo = *(const LAS u32x2*)p0, hi = *(const LAS u32x2*)(p0 + 16); pa0.x = lo.x; pa0.y = lo.y; pa0.z = hi.x; pa0.w = hi.y; }
          { const LAS bf16_t* p1 = PT + (16 + fr) * 40 + 4 * hq; const u32x2 lo = *(const LAS u32x2*)p1, hi = *(const LAS u32x2*)(p1 + 16); pa1.x = lo.x; pa1.y = lo.y; pa1.z = hi.x; pa1.w = hi.y; }
          { const u32x2 lo = *(const LAS u32x2*)(vrow + 4 * hq), hi = *(const LAS u32x2*)(vrow + 16 + 4 * hq); vb.x = lo.x; vb.y = lo.y; vb.z = hi.x; vb.w = hi.y; }
          o0 = __builtin_amdgcn_mfma_f32_16x16x32_bf16(__builtin_bit_cast(bf16x8, pa0), __builtin_bit_cast(bf16x8, vb), o0, 0, 0, 0);
          o1 = __builtin_amdgcn_mfma_f32_16x16x32_bf16(__builtin_bit_cast(bf16x8, pa1), __builtin_bit_cast(bf16x8, vb), o1, 0, 0, 0); }
        { const int pi0 = c * 32 + 4 * hq; bf16_t* op = proj + (rowbase + (dir ? (T - 1 - pi0) : pi0)) * 7168 + 1024 * (1 + dir) + h * 128 + 16 * w + fr;
#pragma unroll
          for (int r = 0; r < 4; ++r) { op[0] = f2bf(o0[r]); op[16 * rstride] = f2bf(o1[r]); op += rstride; } }
    }
#undef HG_LOAD
    if (!sample) { float* so = p.out + (size_t)NTOK * DM + ((((size_t)b * 2 + j) * 2 + dir) * 8 + h) * 16384;
#pragma unroll
        for (int dt = 0; dt < 8; ++dt)
#pragma unroll
            for (int r = 0; r < 4; ++r) so[(16 * dt + 4 * hq + r) * 128 + 16 * w + fr] = S[dt][r];
    }
    __syncthreads();
}

template <int W> __device__ __forceinline__ void pool_prompt_unit(const Params& p, int b, int slab) {
    int tid_l = threadIdx.x; asm volatile("" : "+v"(tid_l)); const int tid = tid_l, cp = tid & 31, seg = tid >> 5; const int ch = slab * 64 + 2 * cp, t0 = seg * 16;
    const bf16_t* proj = (const bf16_t*)(p.ws + WS_PROJ); bf16_t* ycat = (bf16_t*)(p.ws + WS_YCAT);
    float xa[16 + W], xb[16 + W];
#pragma unroll
    for (int i = 0; i < 16 + W; ++i) { const int t = t0 - W / 2 + i; float a = 0.f, bq = 0.f;
        if (t >= 0 && t < 256) { const unsigned v = *(const unsigned*)(proj + ((size_t)b * 256 + t) * 7168 + 5120 + ch); a = __uint_as_float(v << 16); bq = __uint_as_float(v & 0xffff0000u); }
        xa[i] = a; xb[i] = bq; }
    unsigned gvs[16];
#pragma unroll
    for (int k = 0; k < 16; ++k) gvs[k] = *(const unsigned*)(proj + ((size_t)b * 256 + t0 + k) * 7168 + 6144 + ch);
#pragma unroll
    for (int k = 0; k < 16; ++k) { const int t = t0 + k; float sa = 0.f, sb = 0.f;
#pragma unroll
        for (int i = 0; i < W; ++i) { sa += xa[k + i]; sb += xb[k + i]; }
        const int lo = max(t - W / 2, 0), hi = min(t - W / 2 + W, 256); const float inv = __builtin_amdgcn_rcpf((float)(hi - lo));
        const size_t row = (size_t)b * 256 + t; const unsigned gv = gvs[k];
        const float ya = (sa * inv - xa[k + W / 2]) * silu_f(__uint_as_float(gv << 16)), yb = (sb * inv - xb[k + W / 2]) * silu_f(__uint_as_float(gv & 0xffff0000u));
        *(unsigned*)(ycat + row * 2048 + 1024 + ch) = pg8::cvt_pk_bf16(ya, yb); }
}
template <int W> __device__ __forceinline__ void pool_sample_unit(const Params& p, LAS unsigned char* lds, int b, int g, int slab) {
    int tid_l = threadIdx.x; asm volatile("" : "+v"(tid_l)); const int tid = tid_l; const int chb = g * 256 + slab * 16;
    const bf16_t* proj = (const bf16_t*)(p.ws + WS_PROJ); bf16_t* ycat = (bf16_t*)(p.ws + WS_YCAT);
    LAS float* buf = (LAS float*)lds;
    const size_t rowb = (size_t)NPROMPT + (size_t)b * 2048;
    { const int cp = tid & 7, col = tid >> 3; float pa[33], pb[33]; pa[0] = 0.f; pb[0] = 0.f;
#pragma unroll
      for (int r = 0; r < 32; ++r) { const unsigned v = *(const unsigned*)(proj + (rowb + r * 64 + col) * 7168 + 5120 + chb + 2 * cp);
          pa[r + 1] = pa[r] + __uint_as_float(v << 16); pb[r + 1] = pb[r] + __uint_as_float(v & 0xffff0000u); }
#pragma unroll
      for (int r = 0; r < 32; ++r) { const int lo = (r - W / 2) > 0 ? (r - W / 2) : 0, hi = (r - W / 2 + W) < 32 ? (r - W / 2 + W) : 32; const float inv = 1.f / (float)(hi - lo);
          LAS float* dst = buf + r * 1040 + col * 16 + 2 * cp; dst[0] = (pa[hi] - pa[lo]) * inv; dst[1] = (pb[hi] - pb[lo]) * inv; } }
    __syncthreads();
    { const int chl = tid & 15, r = tid >> 4; float pc[65]; pc[0] = 0.f;
#pragma unroll
      for (int col = 0; col < 64; ++col) pc[col + 1] = pc[col] + buf[r * 1040 + col * 16 + chl];
#pragma unroll
      for (int cb = 0; cb < 2; ++cb) { bf16_t zz[32], gg[32];
#pragma unroll
          for (int c2 = 0; c2 < 32; ++c2) { const size_t row = rowb + r * 64 + cb * 32 + c2; zz[c2] = proj[row * 7168 + 5120 + chb + chl]; gg[c2] = proj[row * 7168 + 6144 + chb + chl]; }
#pragma unroll
          for (int c2 = 0; c2 < 32; ++c2) { const int col = cb * 32 + c2; const int lo = (col - W / 2) > 0 ? (col - W / 2) : 0, hi = (col - W / 2 + W) < 64 ? (col - W / 2 + W) : 64; const float inv = 1.f / (float)(hi - lo);
              const size_t row = rowb + r * 64 + col;
              ycat[row * 2048 + 1024 + chb + chl] = f2bf(((pc[hi] - pc[lo]) * inv - bf2f(zz[c2])) * silu_f(bf2f(gg[c2]))); } } }
    __syncthreads();
}

__device__ __forceinline__ void pool_unit(const Params& p, LAS unsigned char* lds, int u) {
    if (u < 64) { const int b = u >> 4, g = (u >> 2) & 3, sq = u & 3;
        for (int s4 = 0; s4 < 4; ++s4) { const int slab = sq * 4 + s4;
            if (g == 0) pool_sample_unit<2>(p, lds, b, g, slab); else if (g == 1) pool_sample_unit<4>(p, lds, b, g, slab); else if (g == 2) pool_sample_unit<8>(p, lds, b, g, slab); else pool_sample_unit<16>(p, lds, b, g, slab); } }
    else { const int v = u - 64, b = v >> 4, slab = v & 15, g = slab >> 2;
        if (g == 0) pool_prompt_unit<2>(p, b, slab); else if (g == 1) pool_prompt_unit<4>(p, b, slab); else if (g == 2) pool_prompt_unit<8>(p, b, slab); else pool_prompt_unit<16>(p, b, slab); }
}
__device__ __forceinline__ void phase_mix_ab(const Params& p, int j, int l_next, LAS unsigned char* lds) {
    const int bid = blockIdx.x, G = gridDim.x;
    if (G >= 128) {
        if (bid < 64) { hgrn_unit(p, lds, j, true, bid >> 4, (bid >> 1) & 7, bid & 1); return; }
        const int idx = bid - 64, nS = G - 64;
        for (int v = idx; v < 256; v += nS) hgrn_unit(p, lds, j, false, v >> 4, (v >> 1) & 7, v & 1);
        for (int u = nS - 1 - idx; u < 320; u += nS) pool_unit(p, lds, u);
        if (l_next < 4) phase_conv(p, l_next, lds, 0, idx, nS);
        if (l_next + 1 < 4) phase_conv(p, l_next + 1, lds, 1, idx, nS);
    } else {
        for (int u = bid; u < 320; u += G) { if (u < 64) hgrn_unit(p, lds, j, true, u >> 4, (u >> 1) & 7, u & 1); else { const int v = u - 64; hgrn_unit(p, lds, j, false, v >> 4, (v >> 1) & 7, v & 1); } }
        for (int u = bid; u < 320; u += G) pool_unit(p, lds, u);
        if (l_next < 4) phase_conv(p, l_next, lds, 0, bid, G);
        if (l_next + 1 < 4) phase_conv(p, l_next + 1, lds, 1, bid, G);
    }
}
__device__ __forceinline__ void phase_combine(const Params& p, int j) {
    int tid_l = threadIdx.x; asm volatile("" : "+v"(tid_l)); const int tid = tid_l, lane = tid & 63, wv = tid >> 6; const int hd = lane >> 3, e0 = (lane & 7) * 16;
    const bf16_t* proj = (const bf16_t*)(p.ws + WS_PROJ); bf16_t* ycat = (bf16_t*)(p.ws + WS_YCAT);
    float gn[16];
#pragma unroll
    for (int i = 0; i < 16; ++i) gn[i] = p.g_onorm[j * 128 + e0 + i];
    for (int tok = blockIdx.x * 8 + wv; tok < NTOK; tok += gridDim.x * 8) {
        const bf16_t* rp = proj + (size_t)tok * 7168 + hd * 128 + e0;
        const u32x4 f0 = *(const u32x4*)(rp + 1024), f1 = *(const u32x4*)(rp + 1024 + 8), b0 = *(const u32x4*)(rp + 2048), b1 = *(const u32x4*)(rp + 2048 + 8), g0 = *(const u32x4*)(rp + 4096), g1 = *(const u32x4*)(rp + 4096 + 8);
        float s[16], gt[16]; float ss = 0.f;
#pragma unroll
        for (int i = 0; i < 4; ++i) { s[2 * i] = __uint_as_float(f0[i] << 16) + __uint_as_float(b0[i] << 16); s[2 * i + 1] = __uint_as_float(f0[i] & 0xffff0000u) + __uint_as_float(b0[i] & 0xffff0000u);
            s[8 + 2 * i] = __uint_as_float(f1[i] << 16) + __uint_as_float(b1[i] << 16); s[8 + 2 * i + 1] = __uint_as_float(f1[i] & 0xffff0000u) + __uint_as_float(b1[i] & 0xffff0000u);
            gt[2 * i] = __uint_as_float(g0[i] << 16); gt[2 * i + 1] = __uint_as_float(g0[i] & 0xffff0000u); gt[8 + 2 * i] = __uint_as_float(g1[i] << 16); gt[8 + 2 * i + 1] = __uint_as_float(g1[i] & 0xffff0000u); }
#pragma unroll
        for (int i = 0; i < 16; ++i) ss += s[i] * s[i];
        ss += __shfl_xor(ss, 1); ss += __shfl_xor(ss, 2); ss += __shfl_xor(ss, 4);
        const float r = rsqrtf(ss * (1.f / 128.f) + EPSV);
        u32x4 w0, w1;
#pragma unroll
        for (int i = 0; i < 4; ++i) { w0[i] = pg8::cvt_pk_bf16(s[2 * i] * r * gn[2 * i] * silu_f(gt[2 * i]), s[2 * i + 1] * r * gn[2 * i + 1] * silu_f(gt[2 * i + 1]));
            w1[i] = pg8::cvt_pk_bf16(s[8 + 2 * i] * r * gn[8 + 2 * i] * silu_f(gt[8 + 2 * i]), s[8 + 2 * i + 1] * r * gn[8 + 2 * i + 1] * silu_f(gt[8 + 2 * i + 1])); }
        bf16_t* yp = ycat + (size_t)tok * 2048 + hd * 128 + e0; *(u32x4*)yp = w0; *(u32x4*)(yp + 8) = w1;
    }
}

constexpr int CM_VNT = 0, CM_WS = 69632, CM_MU = 104448;
__device__ __forceinline__ void phase_mix_c(const Params& p, int j, LAS unsigned char* lds) {
    int tid_l = threadIdx.x; asm volatile("" : "+v"(tid_l)); const int tid = tid_l, lane = tid & 63, w = tid >> 6, fr = lane & 15, hq = lane >> 4;
    const bf16_t* proj = (const bf16_t*)(p.ws + WS_PROJ); bf16_t* ycat = (bf16_t*)(p.ws + WS_YCAT); const float* stats = (const float*)(p.ws + WS_STATS);
    LAS bf16_t* VNT = (LAS bf16_t*)(lds + CM_VNT); LAS bf16_t* WSL = (LAS bf16_t*)(lds + CM_WS); LAS f32x2v* MU = (LAS f32x2v*)(lds + CM_MU);
    for (int unit = blockIdx.x; unit < 768; unit += gridDim.x) {
        const int g = unit & 7, n = unit >> 3; const size_t row0 = (size_t)n * 128;
        u32x4 va[4], vb[4];
        { const int sp_ = tid >> 3, cg_ = (tid & 7) * 32; const bf16_t* s0_ = proj + (row0 + 2 * sp_) * 6144 + 2048 + g * 256 + cg_;
#pragma unroll
          for (int i = 0; i < 4; ++i) { va[i] = *(const u32x4*)(s0_ + 8 * i); vb[i] = *(const u32x4*)(s0_ + 6144 + 8 * i); } }
        if (tid < 128) { float s = 0.f, q = 0.f;
#pragma unroll
            for (int i = 0; i < 8; ++i) { const float* sp = stats + ((size_t)i * NTOK + row0 + tid) * 8; const f32x4 v = *(const f32x4*)sp, v2 = *(const f32x4*)(sp + 4); s += (v[0] + v[2]) + (v2[0] + v2[2]); q += (v[1] + v[3]) + (v2[1] + v2[3]); }
            const float mean = s * (1.f / 2048.f); const float var = fmaxf(q * (1.f / 2048.f) - mean * mean, 0.f); MU[tid] = (f32x2v){mean, rsqrtf(var + EPSV)}; }
        if (unit == (int)blockIdx.x || (gridDim.x & 7) != 0)
        { const int t = tid >> 2, s0 = (tid & 3) * 32; const float* src = p.w_sp + ((size_t)(j * 8 + g) * 128 + t) * 128 + s0;
#pragma unroll
          for (int i = 0; i < 4; ++i) { const f32x4 a = *(const f32x4*)(src + 8 * i), bq = *(const f32x4*)(src + 8 * i + 4);
              u32x4 wv; wv.x = pg8::cvt_pk_bf16(a[0], a[1]); wv.y = pg8::cvt_pk_bf16(a[2], a[3]); wv.z = pg8::cvt_pk_bf16(bq[0], bq[1]); wv.w = pg8::cvt_pk_bf16(bq[2], bq[3]);
              *(LAS u32x4*)(WSL + t * 136 + s0 + 8 * i) = wv; } }
        __syncthreads();
        { const int sp = tid >> 3, cg = (tid & 7) * 32; const f32x2v m0 = MU[2 * sp], m1 = MU[2 * sp + 1];
          const bf16_t* s0 = proj + (row0 + 2 * sp) * 6144 + 2048 + g * 256 + cg; const bf16_t* s1 = s0 + 6144;
          const float* lg = p.ln_g + j * 2048 + g * 256 + cg; const float* lb = p.ln_b + j * 2048 + g * 256 + cg;
#pragma unroll
          for (int i = 0; i < 4; ++i) { const f32x4 g0 = *(const f32x4*)(lg + 8 * i), g1 = *(const f32x4*)(lg + 8 * i + 4), b0 = *(const f32x4*)(lb + 8 * i), b1 = *(const f32x4*)(lb + 8 * i + 4);
#pragma unroll
              for (int q = 0; q < 4; ++q) { const int c = cg + 8 * i + 2 * q; const float ga = (q < 2) ? g0[2 * q] : g1[2 * q - 4], gb = (q < 2) ? g0[2 * q + 1] : g1[2 * q - 3], ba = (q < 2) ? b0[2 * q] : b1[2 * q - 4], bb = (q < 2) ? b0[2 * q + 1] : b1[2 * q - 3];
                  const float x00 = __uint_as_float(va[i][q] << 16), x01 = __uint_as_float(va[i][q] & 0xffff0000u), x10 = __uint_as_float(vb[i][q] << 16), x11 = __uint_as_float(vb[i][q] & 0xffff0000u);
                  *(LAS unsigned*)(VNT + c * 136 + 2 * sp) = pg8::cvt_pk_bf16((x00 - m0.x) * m0.y * ga + ba, (x10 - m1.x) * m1.y * ga + ba);
                  *(LAS unsigned*)(VNT + (c + 1) * 136 + 2 * sp) = pg8::cvt_pk_bf16((x01 - m0.x) * m0.y * gb + bb, (x11 - m1.x) * m1.y * gb + bb); } } }
        __syncthreads();
        bf16x8 af[2][4];
#pragma unroll
        for (int ct = 0; ct < 2; ++ct)
#pragma unroll
            for (int ks = 0; ks < 4; ++ks) af[ct][ks] = *(const LAS bf16x8*)(VNT + (32 * w + 8 * (fr >> 2) + 4 * ct + (fr & 3)) * 136 + 32 * ks + 8 * hq);
        const float* bsp = p.b_sp + (size_t)(j * 8 + g) * 128;
        f32x4 acc[8][2];
#pragma unroll
        for (int tt = 0; tt < 8; ++tt) {
            f32x4 a0 = {0.f, 0.f, 0.f, 0.f}, a1 = a0;
#pragma unroll
            for (int ks = 0; ks < 4; ++ks) { const bf16x8 bf = *(const LAS bf16x8*)(WSL + (16 * tt + fr) * 136 + 32 * ks + 8 * hq);
                a0 = __builtin_amdgcn_mfma_f32_16x16x32_bf16(af[0][ks], bf, a0, 0, 0, 0); a1 = __builtin_amdgcn_mfma_f32_16x16x32_bf16(af[1][ks], bf, a1, 0, 0, 0); }
            acc[tt][0] = a0; acc[tt][1] = a1;
        }
#pragma unroll
        for (int tb = 0; tb < 2; ++tb) {
            u32x4 uu[4], gg[4]; float bs[4]; const int c = g * 256 + 32 * w + 8 * hq;
#pragma unroll
            for (int t4 = 0; t4 < 4; ++t4) { const int tt = tb * 4 + t4; const size_t row = row0 + 16 * tt + fr; bs[t4] = bsp[16 * tt + fr];
                uu[t4] = *(const u32x4*)(proj + row * 6144 + c); gg[t4] = *(const u32x4*)(proj + row * 6144 + 4096 + c); }
#pragma unroll
            for (int t4 = 0; t4 < 4; ++t4) { const int tt = tb * 4 + t4; const size_t row = row0 + 16 * tt + fr; const float bq = bs[t4]; u32x4 o;
#pragma unroll
                for (int ct = 0; ct < 2; ++ct) { const f32x4 a = acc[tt][ct]; const unsigned ux = uu[t4][2 * ct], uy = uu[t4][2 * ct + 1], gx = gg[t4][2 * ct], gy = gg[t4][2 * ct + 1];
                    const float y0 = __uint_as_float(ux << 16) * (a[0] + bq) * silu_f(__uint_as_float(gx << 16)), y1 = __uint_as_float(ux & 0xffff0000u) * (a[1] + bq) * silu_f(__uint_as_float(gx & 0xffff0000u));
                    const float y2 = __uint_as_float(uy << 16) * (a[2] + bq) * silu_f(__uint_as_float(gy << 16)), y3 = __uint_as_float(uy & 0xffff0000u) * (a[3] + bq) * silu_f(__uint_as_float(gy & 0xffff0000u));
                    o[2 * ct] = pg8::cvt_pk_bf16(y0, y1); o[2 * ct + 1] = pg8::cvt_pk_bf16(y2, y3); }
                *(u32x4*)(ycat + row * 2048 + c) = o; }
        }
        __syncthreads();
    }
}

#ifdef DIAG_L
__device__ __forceinline__ void diag_dump_bf16(const Params& p, const bf16_t* buf, int K) {
    for (size_t i = (size_t)blockIdx.x * 512 + threadIdx.x; i < (size_t)NTOK * DM; i += (size_t)gridDim.x * 512) { float a = 0.f; for (int k = 0; k < K; ++k) a += bf2f(buf[i + (size_t)k * NTOK * DM]); p.out[i] = (float)((__float_as_uint(a) * 2654435761u) >> 16) * (1.f / 65536.f); }
}
__device__ __forceinline__ void diag_dump_f32(const Params& p, const float* buf) {
    for (size_t i = (size_t)blockIdx.x * 512 + threadIdx.x; i < (size_t)NTOK * DM; i += (size_t)gridDim.x * 512) p.out[i] = (float)((__float_as_uint(buf[i]) * 2654435761u) >> 16) * (1.f / 65536.f);
}
#endif
__global__ void __launch_bounds__(512, 2) mega_fwd(Params p) {
    extern __shared__ __attribute__((aligned(16))) unsigned char shm[];
    LAS unsigned char* lds = (LAS unsigned char*)shm;
    volatile LAS unsigned* bst = (volatile LAS unsigned*)(lds + LDS_BYTES - 16);
    if (threadIdx.x < 4) bst[threadIdx.x] = 0u;
    __syncthreads();
    XcdBarrier bar = xcd_barrier_post((unsigned*)(p.ws + WS_BAR), bst);
    phase_mod(p, lds);
    cg::this_grid().sync();
    bf16_t* hbuf = (bf16_t*)(p.ws + WS_YCAT); bf16_t* ycat = hbuf; bf16_t* projb = (bf16_t*)(p.ws + WS_PROJ);
#ifdef DIAG_MOD
    { const float* md = (const float*)(p.ws + WS_MOD);
      for (size_t i = (size_t)blockIdx.x * 512 + threadIdx.x; i < (size_t)NTOK * DM; i += (size_t)gridDim.x * 512) p.out[i] = i < 61440 ? md[i] : 0.f;
      return; }
#endif
    for (int l = 0; l < 4; ++l) {
        const int j = l >> 1; const bool ab = (l & 1) == 0;
        phase_row(p, l);
#ifdef DIAG_STOP_LAYER
        if (l == DIAG_STOP_LAYER) {
#ifdef DIAG_BITS
            xcd_barrier(bar);
            for (size_t i = (size_t)blockIdx.x * 512 + threadIdx.x; i < (size_t)NTOK * DM; i += (size_t)gridDim.x * 512) { const unsigned u = __float_as_uint(p.out[i]); p.out[i] = (float)((u * 2654435761u) >> 16) * (1.f / 65536.f); }
#endif
#ifdef DIAG_MOD2
            xcd_barrier(bar);
            { const float* md = (const float*)(p.ws + WS_MOD);
              for (size_t i = (size_t)blockIdx.x * 512 + threadIdx.x; i < (size_t)NTOK * DM; i += (size_t)gridDim.x * 512) p.out[i] = i < 61440 ? md[i] : 0.f; }
#endif
            return; }
#endif
        if (l == 0) phase_conv(p, 0, lds, 0, (int)blockIdx.x, (int)gridDim.x);
        else if (l == 2) phase_conv(p, 2, lds, 2, (int)blockIdx.x, (int)gridDim.x);
        xcd_barrier(bar);
#ifdef DIAG_L
        if (l == DIAG_L && DIAG_S == 0) { unsigned* hb = (unsigned*)hbuf;
            for (size_t i = (size_t)blockIdx.x * 512 + threadIdx.x; i < (size_t)NTOK * DM / 2; i += (size_t)gridDim.x * 512) { const unsigned v = __hip_atomic_load(hb + i, __ATOMIC_RELAXED, __HIP_MEMORY_SCOPE_AGENT);
                p.out[2 * i] = __uint_as_float(v << 16); p.out[2 * i + 1] = __uint_as_float(v & 0xffff0000u); }
            return; }
#endif
        { pg8::StaticOrder S; pg8::Gemm g; g.A = hbuf; g.Bt = (const bf16_t*)(p.ws + ws_win(l)); g.M = NTOK; g.K = 1024;
          if (ab) { g.N = 7168; S.init(g.M, g.N, (int)gridDim.x, (int)blockIdx.x); pg8::EpiBf16S E; E.O = projb; E.ldc = 7168; E.stats = nullptr; E.st_lo = 0; E.st_hi = 0; E.sl_hi = 4; E.kg_hi = 12; E.lbp = (const float*)(p.ws + WS_LB) + j * 2048;
              pg8::gemm_phase<pg8::EpiBf16S, pg8::StaticOrder, false>(lds, g, S, E, nullptr); }
          else { g.N = 6144; S.init(g.M, g.N, (int)gridDim.x, (int)blockIdx.x); pg8::EpiBf16S E; E.O = projb; E.ldc = 6144; E.stats = (float*)(p.ws + WS_STATS); E.st_lo = 8; E.st_hi = 16; E.sl_hi = 0; E.kg_hi = 0; E.lbp = nullptr;
              pg8::gemm_phase<pg8::EpiBf16S, pg8::StaticOrder, false>(lds, g, S, E, nullptr); } }
        xcd_barrier(bar);
#ifdef DIAG_L
        if (l == DIAG_L && DIAG_S == 1) { diag_dump_bf16(p, projb, ab ? 7 : 6); return; }
#endif
        if (ab) { phase_mix_ab(p, j, l + 1, lds); xcd_barrier(bar); phase_combine(p, j); }
        else phase_mix_c(p, j, lds);
        xcd_barrier(bar);
#ifdef DIAG_L
        if (l == DIAG_L && DIAG_S == 2) { diag_dump_bf16(p, ycat, 2); return; }
        if (l == DIAG_L && DIAG_S == 4) {
            for (size_t i = (size_t)blockIdx.x * 512 + threadIdx.x; i < (size_t)NTOK * DM; i += (size_t)gridDim.x * 512) { const size_t rr = i >> 10; const float a = (rr >= DIAG_R0 && rr < DIAG_R1) ? bf2f(ycat[rr * 2048 + (i & 1023) + DIAG_HALF * 1024]) : 0.f;
                p.out[i] = (float)((__float_as_uint(a) * 2654435761u) >> 16) * (1.f / 65536.f); }
            return; }
#endif
        { pg8::StaticOrder S; pg8::Gemm g; g.A = ycat; g.Bt = (const bf16_t*)(p.ws + ws_wout(l)); g.M = NTOK; g.N = 1024; g.K = 2048; S.init(g.M, g.N, (int)gridDim.x, (int)blockIdx.x);
          pg8::EpiBf16S E; E.O = projb; E.ldc = 1024; E.stats = nullptr; E.st_lo = 0; E.st_hi = 0; E.sl_hi = 0; E.kg_hi = 0; E.lbp = nullptr;
          pg8::gemm_phase<pg8::EpiBf16S, pg8::StaticOrder, false>(lds, g, S, E, nullptr); }
        xcd_barrier(bar);
#ifdef DIAG_L
        if (l == DIAG_L && DIAG_S == 3) { diag_dump_f32(p, (const float*)(p.ws + WS_PROJ)); return; }
#endif
    }
    phase_row(p, 4);
}

extern "C" void kernel_launch(void* const* d_in, const int* in_sizes, int n_in, void* d_out, int out_size, void* d_ws, size_t ws_size, hipStream_t stream) {
    static int grid = 0;
    if (grid == 0) {
        if (n_in != 21 || ws_size < WS_END) { fprintf(stderr, "kernel_launch: unexpected n_in %d / ws_size %zu (need %zu)\n", n_in, ws_size, (size_t)WS_END); grid = -1; return; }
        int dev = 0, cus = 0, per_cu = 0;
        hipGetDevice(&dev); hipDeviceGetAttribute(&cus, hipDeviceAttributeMultiprocessorCount, dev);
        if (hipFuncSetAttribute((const void*)mega_fwd, hipFuncAttributeMaxDynamicSharedMemorySize, LDS_BYTES) != hipSuccess) { fprintf(stderr, "kernel_launch: hipFuncSetAttribute failed\n"); grid = -1; return; }
        hipOccupancyMaxActiveBlocksPerMultiprocessor(&per_cu, (const void*)mega_fwd, 512, LDS_BYTES);
        (void)hipGetLastError();
        if (per_cu < 1) { fprintf(stderr, "kernel_launch: occupancy query says %d blocks per CU\n", per_cu); }
        grid = cus;
    }
    if (grid < 0) return;
    hipMemsetAsync((char*)d_ws + WS_BAR, 0, 16384, stream);
    Params p{};
    p.x_prompt = (const float*)d_in[0]; p.x_sample = (const float*)d_in[1]; p.c = (const float*)d_in[2]; p.state_hgrn = (const float*)d_in[3]; p.c_ctx = (const float*)d_in[4];
    p.w_ada = (const float*)d_in[5]; p.b_ada = (const float*)d_in[6]; p.g_pre = (const float*)d_in[7]; p.g_post = (const float*)d_in[8]; p.w_in_ab = (const float*)d_in[9];
    p.w_out_ab = (const float*)d_in[10]; p.lb_logits = (const float*)d_in[11]; p.g_onorm = (const float*)d_in[12]; p.w_pool = (const float*)d_in[13]; p.pool_scale = (const float*)d_in[14];
    p.w_in_c = (const float*)d_in[15]; p.w_out_c = (const float*)d_in[16]; p.ln_g = (const float*)d_in[17]; p.ln_b = (const float*)d_in[18]; p.w_sp = (const float*)d_in[19]; p.b_sp = (const float*)d_in[20];
    p.out = (float*)d_out; p.ws = (unsigned char*)d_ws;
    void* args[] = {&p};
    hipError_t e = hipLaunchCooperativeKernel((const void*)mega_fwd, dim3(grid), dim3(512), args, LDS_BYTES, stream);
    if (e != hipSuccess) fprintf(stderr, "kernel_launch: cooperative launch failed: %s (grid %d)\n", hipGetErrorString(e), grid);
}
```

```cpp
#include <hip/hip_runtime.h>
#include <hip/hip_cooperative_groups.h>
#include <cstdio>
namespace cg = cooperative_groups;
namespace pg8 {
#define PG8_LAS __attribute__((address_space(3)))
typedef unsigned short bf16_t;
typedef short bf16x8 __attribute__((ext_vector_type(8)));
typedef float f32x4 __attribute__((ext_vector_type(4)));
typedef unsigned u32x4 __attribute__((ext_vector_type(4)));
constexpr int BM = 256, BK = 64, HALF = 128, HTB = HALF * BK * 2  , STAGE_BYTES = 8 * HTB, NXCD = 8, WGM = 8;

__host__ __device__ __forceinline__ int lds_byte(int r, int c) { const int st = (r >> 4) * 2 + (c >> 5), rr = r & 15, cc = c & 31, ob = rr * 64 + cc * 2; return st * 1024 + (ob ^ (((ob >> 9) & 1) << 5)); }
__host__ __device__ __forceinline__ void stage_rc(int b, int& R, int& C) { const int st = b / 1024, sb = b % 1024, swz = sb ^ (((sb >> 9) & 1) << 5); R = (st >> 1) * 16 + swz / 64; C = (st & 1) * 32 + (swz % 64) / 2; }
__host__ __device__ __forceinline__ int perm32(int rho) { const int n = rho >> 4, i = rho & 15; return 8 * (i >> 2) + 4 * n + (i & 3); }

struct Unit { int pm, pn; };
struct Gemm { const bf16_t* A; const bf16_t* Bt; int M, N, K; };

struct StaticOrder {
    int nM, nN, nwg, G, c;
    __host__ __device__ void init(int M, int N, int G_, int c_) { nM = M / BM; nN = N / BM; nwg = nM * nN; G = G_; c = c_; }
    __host__ __device__ bool next(int i, Unit& u) const {
        const long L = (long)i * G + c; if (L >= nwg) return false;
        int wgid = (int)L; { const int q = nwg / NXCD, r = nwg % NXCD, xcd = wgid % NXCD, off = wgid / NXCD; wgid = (xcd < r ? xcd * (q + 1) : r * (q + 1) + (xcd - r) * q) + off; }
        const int nig = WGM * nN, gid = wgid / nig, fm = gid * WGM, gsz = (nM - fm) < WGM ? (nM - fm) : WGM;
        u.pm = fm + ((wgid % nig) % gsz); u.pn = (wgid % nig) / gsz; return true;
    }
    __device__ __forceinline__ void a_ready(const Unit&) const {}
    __device__ __forceinline__ void done(const Unit&) const {}
};
__device__ __forceinline__ unsigned cvt_pk_bf16(float lo, float hi) { unsigned r; asm volatile("v_cvt_pk_bf16_f32 %0, %1, %2\n\ts_nop 1" : "=v"(r) : "v"(lo), "v"(hi)); return r; }
typedef float f32x2 __attribute__((ext_vector_type(2)));
struct EpiF32 {
    static constexpr bool PERM = false, AFTER_DRAIN = false;
    float* C; int ldc;
    __device__ __forceinline__ void operator()(const f32x4 (&acc)[2][2][4][2], const Unit& u, int wr, int wc, int fr, int fq) const {
        const int row0 = u.pm * BM + wr * 64 + fr, col0 = u.pn * BM + wc * 32 + 4 * fq;
#pragma unroll
        for (int ai = 0; ai < 2; ++ai)
#pragma unroll
            for (int m = 0; m < 4; ++m) { float* rowp = C + (size_t)(row0 + ai * HALF + m * 16) * ldc + col0;
#pragma unroll
                for (int bj = 0; bj < 2; ++bj)
#pragma unroll
                    for (int n = 0; n < 2; ++n) *(f32x4*)(rowp + bj * HALF + n * 16) = acc[ai][bj][m][n]; }
    }
};
struct EpiBf16S {
    static constexpr bool PERM = true, AFTER_DRAIN = false;
    bf16_t* O; int ldc; float* stats; int st_lo, st_hi; int sl_hi; const float* lbp; int kg_hi;
    __device__ __forceinline__ void operator()(const f32x4 (&acc)[2][2][4][2], const Unit& u, int wr, int wc, int fr, int fq) const {
        const int row0 = u.pm * BM + wr * 64 + fr; const int col0 = u.pn * BM + wc * 32 + 8 * fq;
        const bool dost = (stats != nullptr) && u.pn >= st_lo && u.pn < st_hi;
        const bool dosl = u.pn < sl_hi; const bool dokg = u.pn >= sl_hi && u.pn < kg_hi;
#pragma unroll
        for (int ai = 0; ai < 2; ++ai)
#pragma unroll
            for (int m = 0; m < 4; ++m) { const int row = row0 + ai * HALF + m * 16; bf16_t* rowp = O + (size_t)row * ldc + col0; float s = 0.f, q = 0.f;
#pragma unroll
                for (int bj = 0; bj < 2; ++bj) { f32x4 v0 = acc[ai][bj][m][0] + 0.f, v1 = acc[ai][bj][m][1] + 0.f;
                    if (dokg) { const float* lq = lbp + (col0 + bj * HALF - 256 * sl_hi); const f32x4 l0 = *(const f32x4*)lq, l1 = *(const f32x4*)(lq + 4);
#pragma unroll
                        for (int q4 = 0; q4 < 4; ++q4) { v0[q4] = (1.f - l0[q4]) * __builtin_amdgcn_rcpf(1.f + __expf(v0[q4])); v1[q4] = (1.f - l1[q4]) * __builtin_amdgcn_rcpf(1.f + __expf(v1[q4])); } }
                    if (dosl) {
#pragma unroll
                        for (int q4 = 0; q4 < 4; ++q4) { v0[q4] = v0[q4] * __builtin_amdgcn_rcpf(1.f + __expf(-v0[q4])); v1[q4] = v1[q4] * __builtin_amdgcn_rcpf(1.f + __expf(-v1[q4])); } }
                    u32x4 w; w.x = cvt_pk_bf16(v0[0], v0[1]); w.y = cvt_pk_bf16(v0[2], v0[3]); w.z = cvt_pk_bf16(v1[0], v1[1]); w.w = cvt_pk_bf16(v1[2], v1[3]);
                    *(u32x4*)(rowp + bj * HALF) = w;
                    s += (v0[0] + v0[1]) + (v0[2] + v0[3]) + (v1[0] + v1[1]) + (v1[2] + v1[3]);
                    q += (v0[0] * v0[0] + v0[1] * v0[1]) + (v0[2] * v0[2] + v0[3] * v0[3]) + (v1[0] * v1[0] + v1[1] * v1[1]) + (v1[2] * v1[2] + v1[3] * v1[3]); }
                if (dost) { s += __shfl_xor(s, 16); s += __shfl_xor(s, 32); q += __shfl_xor(q, 16); q += __shfl_xor(q, 32);
                    if (fq == 0) { float* sp = stats + (((size_t)(u.pn - st_lo) * 12288 + row) * 4 + wc) * 2; sp[0] = s; sp[1] = q; } } }
    }
};
template <class Epi, class Sched, bool STAMP = false>
__device__ __forceinline__ void gemm_phase(PG8_LAS unsigned char* lds, const Gemm g, const Sched& S, const Epi& E, unsigned long long* stamps) {
    int tid_l = threadIdx.x; asm volatile("" : "+v"(tid_l));
    const int tid = tid_l, wid = __builtin_amdgcn_readfirstlane(tid >> 6), lane = tid & 63, wr = wid >> 2, wc = wid & 3, fr = lane & 15, fq = lane >> 4;
    const int K = g.K, nt = K / BK;
    int ts_lo = 0, ts_hi = 0, nts = 0; const unsigned long long rt_entry = STAMP ? (unsigned long long)wall_clock64() : 0ull;
#define PG8_STAMP() do { if (STAMP && wid == 0 && nts < 64) { const unsigned long long _c = (unsigned long long)clock64(); \
        ts_lo = (lane == nts) ? (int)(unsigned)_c : ts_lo; ts_hi = (lane == nts) ? (int)(unsigned)(_c >> 32) : ts_hi; ++nts; } } while (0)
    PG8_STAMP();
    unsigned voffA[2], voffB[2];
#pragma unroll
    for (int i = 0; i < 2; ++i) { int R, C; stage_rc(tid * 16 + i * 8192, R, C); const int Rb = Epi::PERM ? ((R & ~31) + perm32(R & 31)) : R;
        voffA[i] = (unsigned)(R * K + C) * 2u; voffB[i] = (unsigned)(Rb * K + C) * 2u; }
    const size_t kstep = (size_t)(BK * 2);
    const size_t hstep = (size_t)HALF * K * 2;
    const size_t tstep = 2 * hstep;
    const unsigned ldsw = (unsigned)wid * 1024u;
    const int aoff = lds_byte(wr * 64 + fr, fq * 8), boff = lds_byte(wc * 32 + fr, fq * 8);
#define PG8_SA(b, h) (((b) * 2 + (h)) * HTB)
#define PG8_SB(b, h) ((4 + (b) * 2 + (h)) * HTB)
#define PG8_STAGE(bufoff, gbase, voff) do { _Pragma("unroll") for (int _i = 0; _i < 2; ++_i) \
        __builtin_amdgcn_global_load_lds((const unsigned*)((const char*)(gbase) + (voff)[_i]), (PG8_LAS unsigned*)(lds + (bufoff) + ldsw + _i * 8192), 16, 0, 0); } while (0)
#define PG8_LDA(dst, b, h) do { _Pragma("unroll") for (int m = 0; m < 4; ++m) _Pragma("unroll") for (int k = 0; k < 2; ++k) dst[m][k] = *(const PG8_LAS bf16x8*)(lds + PG8_SA(b, h) + aoff + m * 2048 + k * 1024); } while (0)
#define PG8_LDB(dst, b, h) do { _Pragma("unroll") for (int n = 0; n < 2; ++n) _Pragma("unroll") for (int k = 0; k < 2; ++k) dst[n][k] = *(const PG8_LAS bf16x8*)(lds + PG8_SB(b, h) + boff + n * 2048 + k * 1024); } while (0)
#define PG8_MMA(ai, bj, At, Bt) do { __builtin_amdgcn_s_setprio(1); _Pragma("unroll") for (int m = 0; m < 4; ++m) _Pragma("unroll") for (int n = 0; n < 2; ++n) _Pragma("unroll") for (int k = 0; k < 2; ++k) \
        acc[ai][bj][m][n] = __builtin_amdgcn_mfma_f32_16x16x32_bf16(Bt[n][k], At[m][k], acc[ai][bj][m][n], 0, 0, 0); __builtin_amdgcn_s_setprio(0); } while (0)
#define PG8_WAIT_V(n) asm volatile("s_waitcnt vmcnt(" #n ")" ::: "memory")
#define PG8_WAIT_L(n) asm volatile("s_waitcnt lgkmcnt(" #n ")" ::: "memory")
#define PG8_BAR __builtin_amdgcn_s_barrier()
#define PG8_SCHED __builtin_amdgcn_sched_barrier(0)
    Unit cur, nxt; int ui = 0;
    if (!S.next(0, cur)) return;
    f32x4 acc[2][2][4][2];
#pragma unroll
    for (int a = 0; a < 2; ++a)
#pragma unroll
        for (int b = 0; b < 2; ++b)
#pragma unroll
            for (int m = 0; m < 4; ++m)
#pragma unroll
                for (int n = 0; n < 2; ++n) acc[a][b][m][n] = (f32x4){0.f, 0.f, 0.f, 0.f};
    bf16x8 At[4][2], B0[2][2], B1[2][2];
    const char* cA = (const char*)g.A + (size_t)cur.pm * tstep; const char* cB = (const char*)g.Bt + (size_t)cur.pn * tstep;
    S.a_ready(cur);
    PG8_STAGE(PG8_SB(0, 0), cB, voffB); PG8_STAGE(PG8_SA(0, 0), cA, voffA); PG8_STAGE(PG8_SB(0, 1), cB + hstep, voffB); PG8_STAGE(PG8_SA(0, 1), cA + hstep, voffA);
    if (wr == 1) PG8_BAR;
    PG8_WAIT_V(4); PG8_BAR;
    PG8_STAGE(PG8_SB(1, 0), cB + kstep, voffB); PG8_STAGE(PG8_SA(1, 0), cA + kstep, voffA); PG8_STAGE(PG8_SB(1, 1), cB + hstep + kstep, voffB);
    PG8_WAIT_V(6); PG8_BAR;
    PG8_STAMP();
    for (;;) {
        const bool has_next = S.next(ui + 1, nxt);
        const char* nA = has_next ? (const char*)g.A + (size_t)nxt.pm * tstep : cA; const char* nB = has_next ? (const char*)g.Bt + (size_t)nxt.pn * tstep : cB;
        for (int t = 0; t < nt; t += 2) {
            const bool last = (t == nt - 2);
            const char* a1 = cA + (size_t)(t + 1) * kstep;
            const char* a2 = last ? nA : cA + (size_t)(t + 2) * kstep; const char* b2 = last ? nB : cB + (size_t)(t + 2) * kstep;
            const char* a3 = a2 + kstep; const char* b3 = b2 + kstep;
            if (last && has_next) S.a_ready(nxt);
            PG8_LDB(B0, 0, 0); PG8_SCHED; PG8_LDA(At, 0, 0); PG8_STAGE(PG8_SA(1, 1), a1 + hstep, voffA);
            PG8_WAIT_L(8); PG8_BAR; PG8_WAIT_L(0); PG8_MMA(0, 0, At, B0); PG8_BAR; PG8_SCHED;
            PG8_LDB(B1, 0, 1); PG8_STAGE(PG8_SB(0, 0), b2, voffB);
            PG8_BAR; PG8_WAIT_L(0); PG8_MMA(0, 1, At, B1); PG8_BAR;
            PG8_LDA(At, 0, 1); PG8_STAGE(PG8_SA(0, 0), a2, voffA);
            PG8_BAR; PG8_WAIT_L(0); PG8_MMA(1, 0, At, B0); PG8_BAR; PG8_SCHED;
            PG8_STAGE(PG8_SB(0, 1), b2 + hstep, voffB);
            PG8_WAIT_V(6); PG8_BAR; PG8_MMA(1, 1, At, B1); PG8_BAR;
            PG8_LDB(B0, 1, 0); PG8_SCHED; PG8_LDA(At, 1, 0); PG8_STAGE(PG8_SA(0, 1), a2 + hstep, voffA);
            PG8_WAIT_L(8); PG8_BAR; PG8_WAIT_L(0); PG8_MMA(0, 0, At, B0); PG8_BAR; PG8_SCHED;
            PG8_LDB(B1, 1, 1); PG8_STAGE(PG8_SB(1, 0), b3, voffB);
            PG8_BAR; PG8_WAIT_L(0); PG8_MMA(0, 1, At, B1); PG8_BAR;
            PG8_LDA(At, 1, 1); PG8_STAGE(PG8_SA(1, 0), a3, voffA);
            PG8_BAR; PG8_WAIT_L(0); PG8_MMA(1, 0, At, B0); PG8_BAR; PG8_SCHED;
            PG8_STAGE(PG8_SB(1, 1), b3 + hstep, voffB);
            PG8_WAIT_V(6); PG8_BAR; PG8_MMA(1, 1, At, B1); PG8_BAR;
        }
        PG8_STAMP();
        if constexpr (!Epi::AFTER_DRAIN) { E(acc, cur, wr, wc, fr, fq); S.done(cur); }
        PG8_STAMP();
        if (!has_next) break;
#pragma unroll
        for (int a = 0; a < 2; ++a)
#pragma unroll
            for (int b = 0; b < 2; ++b)
#pragma unroll
                for (int m = 0; m < 4; ++m)
#pragma unroll
                    for (int n = 0; n < 2; ++n) acc[a][b][m][n] = (f32x4){0.f, 0.f, 0.f, 0.f};
        cur = nxt; cA = nA; cB = nB; ++ui;
    }
    PG8_WAIT_V(0);
    if (wr == 0) PG8_BAR;
    PG8_BAR;
    if constexpr (Epi::AFTER_DRAIN) { E.fused(acc, cur, wr, wc, fr, fq, lds, wid, lane); S.done(cur); }
    PG8_STAMP();
    if (STAMP && wid == 0) { stamps[lane] = lane < nts ? (((unsigned long long)(unsigned)ts_hi << 32) | (unsigned)ts_lo) : 0ull;
        if (lane == 62) stamps[62] = rt_entry; if (lane == 63) stamps[63] = (unsigned long long)wall_clock64(); }
#undef PG8_STAMP
#undef PG8_SA
#undef PG8_SB
#undef PG8_STAGE
#undef PG8_LDA
#undef PG8_LDB
#undef PG8_MMA
#undef PG8_WAIT_V
#undef PG8_WAIT_L
#undef PG8_BAR
#undef PG8_SCHED
}
}

#define LAS __attribute__((address_space(3)))
using pg8::bf16_t; using pg8::bf16x8; using pg8::f32x4; using pg8::u32x4;
typedef short bf16x4 __attribute__((ext_vector_type(4)));
typedef unsigned u32x2 __attribute__((ext_vector_type(2)));
typedef float f32x2v __attribute__((ext_vector_type(2)));
constexpr int NTOK = 12288, NPROMPT = 4096, DM = 1024;
constexpr int LDS_BYTES = 147456;
constexpr float EPSV = 1e-6f;
constexpr size_t WS_PROJ = 0;
constexpr size_t WS_YCAT = 176160768;
constexpr size_t WS_WIN  = WS_YCAT + 50331648;
constexpr size_t WS_WOUT = WS_WIN + 14680064;
constexpr size_t WS_STATS = WS_WOUT + 4194304;
constexpr size_t WS_MOD = WS_STATS + 3145728;
constexpr size_t WS_LB = WS_MOD + 245760;
constexpr size_t WS_BAR = WS_LB + 16384;
constexpr size_t WS_WIN2 = WS_BAR + 16384;
constexpr size_t WS_WOUT2 = WS_WIN2 + 14680064;
constexpr size_t WS_END = WS_WOUT2 + 4194304;
__device__ __forceinline__ size_t ws_win(int l) { return (l & 1) ? WS_WIN2 : WS_WIN; }
__device__ __forceinline__ size_t ws_wout(int l) { return (l & 1) ? WS_WOUT2 : WS_WOUT; }

struct Params {
    const float *x_prompt, *x_sample, *c, *state_hgrn, *c_ctx, *w_ada, *b_ada, *g_pre, *g_post, *w_in_ab, *w_out_ab, *lb_logits, *g_onorm, *w_pool, *pool_scale,
        *w_in_c, *w_out_c, *ln_g, *ln_b, *w_sp, *b_sp;
    float* out; unsigned char* ws;
};

__device__ __forceinline__ float bf2f(bf16_t b) { return __uint_as_float(((unsigned)b) << 16); }
__device__ __forceinline__ bf16_t f2bf(float f) { unsigned u = __float_as_uint(f); u += 0x7FFFu + ((u >> 16) & 1u); return (bf16_t)(u >> 16); }
__device__ __forceinline__ float silu_f(float x) { return x * __builtin_amdgcn_rcpf(1.f + __expf(-x)); }
__device__ __forceinline__ float wave_sum(float v) { v += __shfl_xor(v, 1); v += __shfl_xor(v, 2); v += __shfl_xor(v, 4); v += __shfl_xor(v, 8); v += __shfl_xor(v, 16); v += __shfl_xor(v, 32); return v; }

#define XB_TMO      128
#define XB_XCNT(j)  (256  + 64 * (j))
#define XB_XSUB(j)  (1280 + 64 * (j))
#define XB_XGEN(j)  (2304 + 64 * (j))
#define XB_TOP      3328
#define XB_TOPGEN   3392
#define XCD_BAR_WORDS 3456
#define XB_SPIN_CAP (1u << 20)
__device__ __forceinline__ unsigned xb_ld(unsigned* p)              { return __hip_atomic_load(p, __ATOMIC_RELAXED, __HIP_MEMORY_SCOPE_AGENT); }
__device__ __forceinline__ unsigned xb_add(unsigned* p, unsigned v) { return __hip_atomic_fetch_add(p, v, __ATOMIC_RELAXED, __HIP_MEMORY_SCOPE_AGENT); }
__device__ __forceinline__ unsigned xb_xcc_id() { return (unsigned)__builtin_amdgcn_s_getreg((3 << 11) | 20) & 0xFu; }
#define XB_SPIN(cond, bar) do { unsigned _sp = 0; while (cond) { __builtin_amdgcn_s_sleep(1); \
    if ((++_sp & 255u) == 0u) { if (xb_ld(&(bar)[XB_TMO])) break; if (_sp > XB_SPIN_CAP) { atomicAdd(&(bar)[XB_TMO], 1u); break; } } } } while (0)
struct XcdBarrier { unsigned* bar; unsigned x; volatile LAS unsigned* st; };
__device__ __forceinline__ XcdBarrier xcd_barrier_post(unsigned* bar, volatile LAS unsigned* st) {
    XcdBarrier b; b.bar = bar; b.x = xb_xcc_id(); b.st = st;
    if (threadIdx.x == 0) (void)xb_add(&bar[XB_XCNT(b.x)], 1u);
    return b;
}
__device__ __forceinline__ void xcd_barrier_complete(unsigned* bar, unsigned x, unsigned& nloc, unsigned& nx) {
    const unsigned G = gridDim.x * gridDim.y * gridDim.z;
    unsigned sum, cnt, mine, sp = 0u;
    for (;;) {
        sum = 0u; cnt = 0u; mine = 0u;
#pragma unroll
        for (unsigned j = 0; j < 16; ++j) { const unsigned c = xb_ld(&bar[XB_XCNT(j)]); sum += c; cnt += (c > 0u) ? 1u : 0u; mine = (j == x) ? c : mine; }
        if (sum == G) break;
        __builtin_amdgcn_s_sleep(1);
        if ((++sp & 255u) == 0u) { if (xb_ld(&bar[XB_TMO])) break; if (sp > XB_SPIN_CAP) { atomicAdd(&bar[XB_TMO], 1u); break; } }
    }
    nloc = mine > 0u ? mine : 1u; nx = cnt > 0u ? cnt : 1u;
}
__device__ __forceinline__ void xcd_barrier(const XcdBarrier& b) {
    asm volatile("s_waitcnt vmcnt(0)" ::: "memory");
    __syncthreads();
    if (threadIdx.x == 0) {
        unsigned* bar = b.bar;
        __builtin_amdgcn_s_waitcnt(0);
        unsigned nloc = b.st[0], nx = b.st[1];
        if (nloc == 0u) { xcd_barrier_complete(bar, b.x, nloc, nx); b.st[0] = nloc; b.st[1] = nx; }
        const unsigned old = xb_add(&bar[XB_XSUB(b.x)], 1u);
        const unsigned gen = old / nloc;
        if (old + 1u == (gen + 1u) * nloc) {
            __builtin_amdgcn_fence(__ATOMIC_RELEASE, "agent");
            asm volatile("s_waitcnt vmcnt(0)" ::: "memory");
            const unsigned og = xb_add(&bar[XB_TOP], 1u);
            const unsigned tg = og / nx;
            if (og + 1u == (tg + 1u) * nx) xb_add(&bar[XB_TOPGEN], 1u);
            else XB_SPIN(xb_ld(&bar[XB_TOPGEN]) == tg, bar);
            __builtin_amdgcn_fence(__ATOMIC_ACQUIRE, "agent");
            xb_add(&bar[XB_XGEN(b.x)], 1u);
            asm volatile("s_waitcnt vmcnt(0)" ::: "memory");
        } else {
            XB_SPIN(xb_ld(&bar[XB_XGEN(b.x)]) == gen, bar);
            __builtin_amdgcn_fence(__ATOMIC_ACQUIRE, "agent");
            asm volatile("s_waitcnt vmcnt(0)" ::: "memory");
        }
    }
    __syncthreads();
}

__device__ __forceinline__ void phase_mod(const Params& p, LAS unsigned char* lds) {
    int tid_l = threadIdx.x; asm volatile("" : "+v"(tid_l)); const int tid = tid_l;
    LAS float* sc = (LAS float*)lds;
    LAS float* red = sc + 5 * 1024;
    for (int i = tid; i < 5 * 1024; i += 512) { const int n = i >> 10, k = i & 1023; const float v = (n == 0) ? p.c_ctx[k] : p.c[(n - 1) * 1024 + k]; sc[i] = silu_f(v); }
    __syncthreads();
    float* mod = (float*)(p.ws + WS_MOD);
    for (int unit = blockIdx.x; unit < 192; unit += gridDim.x) {
        const int l = unit / 48, c0 = (unit % 48) * 64, cc = tid & 63, ks = tid >> 6;
        const float* w = p.w_ada + (size_t)l * 1024 * 3072 + c0 + cc;
        float a0 = 0.f, a1 = 0.f, a2 = 0.f, a3 = 0.f, a4 = 0.f;
#pragma unroll 8
        for (int k = ks * 128; k < ks * 128 + 128; ++k) { const float wv = __builtin_nontemporal_load(w + (size_t)k * 3072);
            a0 += sc[k] * wv; a1 += sc[1024 + k] * wv; a2 += sc[2048 + k] * wv; a3 += sc[3072 + k] * wv; a4 += sc[4096 + k] * wv; }
        LAS float* r = red + (ks * 64 + cc) * 5; r[0] = a0; r[1] = a1; r[2] = a2; r[3] = a3; r[4] = a4;
        __syncthreads();
        if (tid < 320) { const int c2 = tid & 63, n = tid >> 6; float s = 0.f;
#pragma unroll
            for (int k8 = 0; k8 < 8; ++k8) s += red[(k8 * 64 + c2) * 5 + n];
            mod[(size_t)(l * 5 + n) * 3072 + c0 + c2] = s + p.b_ada[l * 3072 + c0 + c2]; }
        __syncthreads();
    }
    float* LB = (float*)(p.ws + WS_LB);
    for (int i = blockIdx.x * 512 + tid; i < 2048; i += gridDim.x * 512) { const float l0 = p.lb_logits[i], l1 = p.lb_logits[2048 + i];
        LB[i] = 0.f; LB[2048 + i] = 1.f / (1.f + __expf(l0 - l1)); }
}

__device__ __forceinline__ void phase_row(const Params& p, int l) {
    int tid_l = threadIdx.x; asm volatile("" : "+v"(tid_l)); const int tid = tid_l, lane = tid & 63, wv = tid >> 6;
    const float* mod = (const float*)(p.ws + WS_MOD);
    const bf16_t* ybuf = (const bf16_t*)(p.ws + WS_PROJ);
    bf16_t* hbuf = (bf16_t*)(p.ws + WS_YCAT);
    const int rstep = gridDim.x * 8;
    for (int row0 = blockIdx.x * 8 + wv; row0 < NTOK; row0 += 2 * rstep) {
        int rows[2]; rows[0] = row0; rows[1] = (row0 + rstep < NTOK) ? row0 + rstep : row0;
        int nn[2]; f32x4 x[2][4], y[2][4];
#pragma unroll
        for (int q = 0; q < 2; ++q) { const int row = rows[q]; nn[q] = row < NPROMPT ? 0 : 1 + ((row - NPROMPT) >> 11);
            const float* xsrc = (l == 0) ? (row < NPROMPT ? p.x_prompt + (size_t)row * DM : p.x_sample + (size_t)(row - NPROMPT) * DM) : p.out + (size_t)row * DM;
#pragma unroll
            for (int i = 0; i < 4; ++i) x[q][i] = *(const f32x4*)(xsrc + (i * 64 + lane) * 4);
            if (l > 0) {
#pragma unroll
                for (int i = 0; i < 4; ++i) { const u32x2 yv = *(const u32x2*)(ybuf + (size_t)row * DM + (i * 64 + lane) * 4);
                    y[q][i] = (f32x4){__uint_as_float(yv.x << 16), __uint_as_float(yv.x & 0xffff0000u), __uint_as_float(yv.y << 16), __uint_as_float(yv.y & 0xffff0000u)}; } } }
        if (l > 0) {
            float ss[2];
#pragma unroll
            for (int q = 0; q < 2; ++q) { ss[q] = 0.f;
#pragma unroll
                for (int i = 0; i < 4; ++i) ss[q] += y[q][i][0] * y[q][i][0] + y[q][i][1] * y[q][i][1] + y[q][i][2] * y[q][i][2] + y[q][i][3] * y[q][i][3]; }
            ss[0] = wave_sum(ss[0]); ss[1] = wave_sum(ss[1]);
            const float* gp = p.g_post + (l - 1) * 1024;
#pragma unroll
            for (int q = 0; q < 2; ++q) { const float r = rsqrtf(ss[q] * (1.f / 1024.f) + EPSV); const float* gt = mod + (size_t)((l - 1) * 5 + nn[q]) * 3072 + 2048;
#pragma unroll
                for (int i = 0; i < 4; ++i) { const int col = (i * 64 + lane) * 4; const f32x4 g = *(const f32x4*)(gt + col), qq = *(const f32x4*)(gp + col); x[q][i] = x[q][i] + g * (y[q][i] * r * qq); } }
        }
#pragma unroll
        for (int q = 0; q < 2; ++q)
#pragma unroll
            for (int i = 0; i < 4; ++i) *(f32x4*)(p.out + (size_t)rows[q] * DM + (i * 64 + lane) * 4) = x[q][i];
        if (l < 4) {
            float ss[2];
#pragma unroll
            for (int q = 0; q < 2; ++q) { ss[q] = 0.f;
#pragma unroll
                for (int i = 0; i < 4; ++i) ss[q] += x[q][i][0] * x[q][i][0] + x[q][i][1] * x[q][i][1] + x[q][i][2] * x[q][i][2] + x[q][i][3] * x[q][i][3]; }
            ss[0] = wave_sum(ss[0]); ss[1] = wave_sum(ss[1]);
            const float* gp = p.g_pre + l * 1024;
#pragma unroll
            for (int q = 0; q < 2; ++q) { const float r = rsqrtf(ss[q] * (1.f / 1024.f) + EPSV); const float* sh = mod + (size_t)(l * 5 + nn[q]) * 3072; const float* scl = sh + 1024;
#pragma unroll
                for (int i = 0; i < 4; ++i) { const int col = (i * 64 + lane) * 4; const f32x4 a = *(const f32x4*)(sh + col), sv = *(const f32x4*)(scl + col), g = *(const f32x4*)(gp + col);
                    const f32x4 hv = x[q][i] * r * g * (sv + 1.f) + a; u32x2 w; w.x = pg8::cvt_pk_bf16(hv[0], hv[1]); w.y = pg8::cvt_pk_bf16(hv[2], hv[3]);
                    *(u32x2*)(hbuf + (size_t)rows[q] * DM + col) = w; } }
        }
    }
}

__device__ __forceinline__ void conv_tile(const float* W, int K, int N, bf16_t* Wt, int kt, int nt, LAS unsigned char* lds) {
    int tid_l = threadIdx.x; asm volatile("" : "+v"(tid_l)); const int tid = tid_l; LAS float* tile = (LAS float*)lds;
    const int k0 = kt * 64, n0 = nt * 64;
#pragma unroll
    for (int it = 0; it < 2; ++it) { const int r = it * 32 + (tid >> 4), c4 = (tid & 15) * 4; const f32x4 v = __builtin_nontemporal_load((const f32x4*)(W + (size_t)(k0 + r) * N + n0 + c4));
        tile[r * 65 + c4] = v[0]; tile[r * 65 + c4 + 1] = v[1]; tile[r * 65 + c4 + 2] = v[2]; tile[r * 65 + c4 + 3] = v[3]; }
    __syncthreads();
    { const int nn = tid >> 3, k8 = (tid & 7) * 8; u32x4 w;
      w.x = pg8::cvt_pk_bf16(tile[(k8 + 0) * 65 + nn], tile[(k8 + 1) * 65 + nn]); w.y = pg8::cvt_pk_bf16(tile[(k8 + 2) * 65 + nn], tile[(k8 + 3) * 65 + nn]);
      w.z = pg8::cvt_pk_bf16(tile[(k8 + 4) * 65 + nn], tile[(k8 + 5) * 65 + nn]); w.w = pg8::cvt_pk_bf16(tile[(k8 + 6) * 65 + nn], tile[(k8 + 7) * 65 + nn]);
      *(u32x4*)(Wt + (size_t)(n0 + nn) * K + k0 + k8) = w; }
    __syncthreads();
}
__device__ __forceinline__ void fold_unit(const Params& p, int j, int fu, LAS unsigned char* lds, bf16_t* Wt) {
    int tid_l = threadIdx.x; asm volatile("" : "+v"(tid_l)); const int tid = tid_l; const int g = fu >> 5, et = (fu >> 3) & 3, kt = fu & 7; const int e0 = et * 64, k0 = kt * 128;
    LAS float* As = (LAS float*)lds;
    LAS float* Bs = As + 32 * 64;
    const float* wp = p.w_pool + (size_t)(j * 4 + g) * 65536; const float* wi = p.w_in_ab + (size_t)j * 1024 * 7168 + 5120 + g * 256;
    const int e4 = (tid & 15) * 4, k4 = (tid >> 4) * 4;
    float acc[4][4];
#pragma unroll
    for (int i = 0; i < 4; ++i)
#pragma unroll
        for (int q = 0; q < 4; ++q) acc[i][q] = 0.f;
    for (int c0 = 0; c0 < 256; c0 += 32) {
        { const int r = tid >> 4, c4 = (tid & 15) * 4; const f32x4 v = *(const f32x4*)(wp + (size_t)(c0 + r) * 256 + e0 + c4); *(LAS f32x4*)(As + r * 64 + c4) = v; }
        { const int kk = tid >> 2, cc = (tid & 3) * 8; const float* src = wi + (size_t)(k0 + kk) * 7168 + c0 + cc; const f32x4 v0 = *(const f32x4*)src, v1 = *(const f32x4*)(src + 4);
          LAS float* d = Bs + kk * 33 + cc; d[0] = v0[0]; d[1] = v0[1]; d[2] = v0[2]; d[3] = v0[3]; d[4] = v1[0]; d[5] = v1[1]; d[6] = v1[2]; d[7] = v1[3]; }
        __syncthreads();
#pragma unroll 8
        for (int c = 0; c < 32; ++c) { const f32x4 a = *(LAS f32x4*)(As + c * 64 + e4);
#pragma unroll
            for (int i = 0; i < 4; ++i) { const float bv = Bs[(k4 + i) * 33 + c]; acc[i][0] += bv * a[0]; acc[i][1] += bv * a[1]; acc[i][2] += bv * a[2]; acc[i][3] += bv * a[3]; } }
        __syncthreads();
    }
#pragma unroll
    for (int q = 0; q < 4; ++q) { const int e = g * 256 + e0 + e4 + q; const float ps = p.pool_scale[j * 1024 + e];
        u32x2 w; w.x = pg8::cvt_pk_bf16(acc[0][q] * ps, acc[1][q] * ps); w.y = pg8::cvt_pk_bf16(acc[2][q] * ps, acc[3][q] * ps);
        *(u32x2*)(Wt + (size_t)(5120 + e) * 1024 + k0 + k4) = w; }
}
__device__ __forceinline__ void conv_tile2(const float* W0, int K0, int N0, bf16_t* Wt0, int kt0, int nt0, const float* W1, int K1, int N1, bf16_t* Wt1, int kt1, int nt1, LAS unsigned char* lds) {
    int tid_l = threadIdx.x; asm volatile("" : "+v"(tid_l)); const int tid = tid_l; LAS float* tileA = (LAS float*)lds; LAS float* tileB = tileA + 64 * 65;
    f32x4 va[2], vb[2];
#pragma unroll
    for (int it = 0; it < 2; ++it) { const int r = it * 32 + (tid >> 4), c4 = (tid & 15) * 4;
        va[it] = __builtin_nontemporal_load((const f32x4*)(W0 + (size_t)(kt0 * 64 + r) * N0 + nt0 * 64 + c4)); vb[it] = __builtin_nontemporal_load((const f32x4*)(W1 + (size_t)(kt1 * 64 + r) * N1 + nt1 * 64 + c4)); }
#pragma unroll
    for (int it = 0; it < 2; ++it) { const int r = it * 32 + (tid >> 4), c4 = (tid & 15) * 4;
        tileA[r * 65 + c4] = va[it][0]; tileA[r * 65 + c4 + 1] = va[it][1]; tileA[r * 65 + c4 + 2] = va[it][2]; tileA[r * 65 + c4 + 3] = va[it][3];
        tileB[r * 65 + c4] = vb[it][0]; tileB[r * 65 + c4 + 1] = vb[it][1]; tileB[r * 65 + c4 + 2] = vb[it][2]; tileB[r * 65 + c4 + 3] = vb[it][3]; }
    __syncthreads();
    { const int nn = tid >> 3, k8 = (tid & 7) * 8; u32x4 w;
      w.x = pg8::cvt_pk_bf16(tileA[(k8 + 0) * 65 + nn], tileA[(k8 + 1) * 65 + nn]); w.y = pg8::cvt_pk_bf16(tileA[(k8 + 2) * 65 + nn], tileA[(k8 + 3) * 65 + nn]);
      w.z = pg8::cvt_pk_bf16(tileA[(k8 + 4) * 65 + nn], tileA[(k8 + 5) * 65 + nn]); w.w = pg8::cvt_pk_bf16(tileA[(k8 + 6) * 65 + nn], tileA[(k8 + 7) * 65 + nn]);
      *(u32x4*)(Wt0 + (size_t)(nt0 * 64 + nn) * K0 + kt0 * 64 + k8) = w;
      w.x = pg8::cvt_pk_bf16(tileB[(k8 + 0) * 65 + nn], tileB[(k8 + 1) * 65 + nn]); w.y = pg8::cvt_pk_bf16(tileB[(k8 + 2) * 65 + nn], tileB[(k8 + 3) * 65 + nn]);
      w.z = pg8::cvt_pk_bf16(tileB[(k8 + 4) * 65 + nn], tileB[(k8 + 5) * 65 + nn]); w.w = pg8::cvt_pk_bf16(tileB[(k8 + 6) * 65 + nn], tileB[(k8 + 7) * 65 + nn]);
      *(u32x4*)(Wt1 + (size_t)(nt1 * 64 + nn) * K1 + kt1 * 64 + k8) = w; }
    __syncthreads();
}
__device__ __forceinline__ void phase_conv(const Params& p, int l, LAS unsigned char* lds, int mode, int wid, int nw) {
    const int j = l >> 1; const bool ab = (l & 1) == 0;
    const float* Win = ab ? p.w_in_ab + (size_t)j * 1024 * 7168 : p.w_in_c + (size_t)j * 1024 * 6144; const int Nin = ab ? 7168 : 6144;
    const float* Wout = ab ? p.w_out_ab + (size_t)j * 2048 * 1024 : p.w_out_c + (size_t)j * 2048 * 1024;
    bf16_t* WtIn = (bf16_t*)(p.ws + ws_win(l)); bf16_t* WtOut = (bf16_t*)(p.ws + ws_wout(l));
    const int n_in = (mode == 2) ? 0 : 1536, n_out = (mode == 1) ? 0 : 512, n_fold = (ab && mode != 2) ? 128 : 0, n_t = n_in + n_out;
    for (int u = wid; u < n_t; u += 2 * nw) {
        const float* W0; int K0, N0, kt0, nt0; bf16_t* T0;
        if (u < n_in) { nt0 = u >> 4; kt0 = u & 15; if (ab && nt0 >= 80) nt0 += 16; W0 = Win; K0 = 1024; N0 = Nin; T0 = WtIn; } else { const int v = u - n_in; kt0 = v & 31; nt0 = v >> 5; W0 = Wout; K0 = 2048; N0 = 1024; T0 = WtOut; }
        const int u1 = u + nw;
        if (u1 < n_t) { const float* W1; int K1, N1, kt1, nt1; bf16_t* T1;
            if (u1 < n_in) { nt1 = u1 >> 4; kt1 = u1 & 15; if (ab && nt1 >= 80) nt1 += 16; W1 = Win; K1 = 1024; N1 = Nin; T1 = WtIn; } else { const int v = u1 - n_in; kt1 = v & 31; nt1 = v >> 5; W1 = Wout; K1 = 2048; N1 = 1024; T1 = WtOut; }
            conv_tile2(W0, K0, N0, T0, kt0, nt0, W1, K1, N1, T1, kt1, nt1, lds); }
        else conv_tile(W0, K0, N0, T0, kt0, nt0, lds);
    }
    for (int u = wid; u < n_fold; u += nw) fold_unit(p, j, u, lds, WtIn);
}

constexpr int HG_QS = 0, HG_KS = 8704, HG_KT = 17408, HG_VT = 27648, HG_FAC = 37888, HG_BUF = 39424, HG_TOT = 2 * HG_BUF, HG_PT = HG_TOT + 2048;
__device__ __forceinline__ float clampe(float v) { return fminf(fmaxf(v, -80.f), 80.f); }
__device__ __forceinline__ void hgrn_unit(const Params& p, LAS unsigned char* lds, int j, bool sample, int b, int h, int dir) {
    int tid_l = threadIdx.x; asm volatile("" : "+v"(tid_l)); const int tid = tid_l, lane = tid & 63, w = tid >> 6, fr = lane & 15, hq = lane >> 4;
    const int T = sample ? 2048 : 256, nch = T >> 5;
    const size_t rowbase = sample ? (size_t)NPROMPT + (size_t)b * 2048 : (size_t)b * 256;
    bf16_t* proj = (bf16_t*)(p.ws + WS_PROJ);
    const int d = tid & 127, tq = tid >> 7;
    const float lbv = ((const float*)(p.ws + WS_LB))[(j * 2 + dir) * 1024 + h * 128 + d], oml = 1.f - lbv;
    f32x4 S[8];
    if (sample) { const float* s0 = p.state_hgrn + ((((size_t)b * 2 + j) * 2 + dir) * 8 + h) * 16384;
#pragma unroll
        for (int dt = 0; dt < 8; ++dt)
#pragma unroll
            for (int r = 0; r < 4; ++r) S[dt][r] = s0[(16 * dt + 4 * hq + r) * 128 + 16 * w + fr];
    } else {
#pragma unroll
        for (int dt = 0; dt < 8; ++dt) S[dt] = (f32x4){0.f, 0.f, 0.f, 0.f};
    }
    LAS float* TOT = (LAS float*)(lds + HG_TOT);
    bf16_t nq[8], nf[8], nv[8];
    const size_t cq = (size_t)h * 128 + d, cf = 1024 * (1 + dir) + (size_t)h * 128 + d, cv = 3072 + (size_t)h * 128 + d;
    const long rstride = dir ? -7168 : 7168;
#define HG_LOAD(c) do { const int pi0 = (c) * 32 + 8 * tq; const bf16_t* rp = proj + (rowbase + (dir ? (T - 1 - pi0) : pi0)) * 7168; \
        _Pragma("unroll") for (int i = 0; i < 8; ++i) { nq[i] = rp[cq]; nf[i] = rp[cf]; nv[i] = rp[cv]; rp += rstride; } } while (0)
    HG_LOAD(0);
    for (int c = 0; c < nch; ++c) {
        LAS unsigned char* buf = lds + (c & 1) * HG_BUF;
        LAS bf16_t* QS = (LAS bf16_t*)(buf + HG_QS); LAS bf16_t* KS = (LAS bf16_t*)(buf + HG_KS); LAS bf16_t* KT = (LAS bf16_t*)(buf + HG_KT); LAS bf16_t* VT = (LAS bf16_t*)(buf + HG_VT);
        LAS float* FAC = (LAS float*)(buf + HG_FAC);
        float Pc[8], kk[8], qs[8]; float pr = 1.f;
#pragma unroll
        for (int i = 0; i < 8; ++i) { const float k = bf2f(nf[i]); kk[i] = k; pr *= fmaxf(1.f - k, 1e-3f); Pc[i] = pr;     qs[i] = bf2f(nq[i]); }
        const float cs = __logf(pr);
        TOT[tq * 128 + d] = cs;
        __syncthreads();
        const float t0 = TOT[d], t1 = TOT[128 + d], t2 = TOT[256 + d], t3 = TOT[384 + d];
        const float off = (tq > 0 ? t0 : 0.f) + (tq > 1 ? t1 : 0.f) + (tq > 2 ? t2 : 0.f);
        const float R = t0 + t1, Bl = R + t2 + t3;
        bf16_t kbs[8];
        const float ebase = __expf(clampe(off - R));
#pragma unroll
        for (int i = 0; i < 8; ++i) { const int tl = 8 * tq + i;
            const float eq = fminf(fmaxf(ebase * Pc[i], 1e-30f), 1e30f), ek = __builtin_amdgcn_rcpf(eq);
            const unsigned qk = pg8::cvt_pk_bf16(qs[i] * eq, kk[i] * ek); const bf16_t qb = (bf16_t)(qk & 0xffffu), kb = (bf16_t)(qk >> 16);
            QS[tl * 136 + d] = qb; KS[tl * 136 + d] = kb; kbs[i] = kb; }
        { u32x4 kw, vw; kw.x = (unsigned)kbs[0] | ((unsigned)kbs[1] << 16); kw.y = (unsigned)kbs[2] | ((unsigned)kbs[3] << 16); kw.z = (unsigned)kbs[4] | ((unsigned)kbs[5] << 16); kw.w = (unsigned)kbs[6] | ((unsigned)kbs[7] << 16);
          vw.x = (unsigned)nv[0] | ((unsigned)nv[1] << 16); vw.y = (unsigned)nv[2] | ((unsigned)nv[3] << 16); vw.z = (unsigned)nv[4] | ((unsigned)nv[5] << 16); vw.w = (unsigned)nv[6] | ((unsigned)nv[7] << 16);
          *(LAS u32x4*)(KT + d * 40 + 8 * tq) = kw; *(LAS u32x4*)(VT + d * 40 + 8 * tq) = vw; }
        if (tq == 0) { FAC[d] = __expf(R); FAC[128 + d] = __expf(Bl); FAC[256 + d] = __expf(Bl - R); }
        if (c + 1 < nch) HG_LOAD(c + 1);
        __syncthreads();
        LAS bf16_t* PT = (LAS bf16_t*)(lds + HG_PT);
        const int wu = __builtin_amdgcn_readfirstlane(w);
        if (wu < 3) { const int sb = (wu == 2) ? 1 : 0, tb = (wu >= 1) ? 1 : 0;
            f32x4 sc = {0.f, 0.f, 0.f, 0.f};
#pragma unroll
            for (int ks = 0; ks < 4; ++ks) {
                const bf16x8 a = *(LAS bf16x8*)(KS + (16 * sb + fr) * 136 + ks * 32 + hq * 8), bq = *(LAS bf16x8*)(QS + (16 * tb + fr) * 136 + ks * 32 + hq * 8);
                sc = __builtin_amdgcn_mfma_f32_16x16x32_bf16(a, bq, sc, 0, 0, 0); }
            if (wu != 1) {
#pragma unroll
                for (int r = 0; r < 4; ++r) sc[r] = (fr >= 4 * hq + r) ? sc[r] : 0.f; }
            else {
#pragma unroll
                for (int r = 0; r < 4; ++r) sc[r] = sc[r] + 0.f; }
            u32x2 pk; pk.x = pg8::cvt_pk_bf16(sc[0], sc[1]); pk.y = pg8::cvt_pk_bf16(sc[2], sc[3]);
            *(LAS u32x2*)(PT + (tb * 16 + fr) * 40 + 16 * sb + 4 * hq) = pk;
        } else if (wu == 3) { u32x2 z; z.x = 0u; z.y = 0u; *(LAS u32x2*)(PT + fr * 40 + 16 + 4 * hq) = z; }
        const LAS bf16_t* vrow = VT + (16 * w + fr) * 40;
        f32x4 o0 = {0.f, 0.f, 0.f, 0.f}, o1 = o0;
#pragma unroll
        for (int ks = 0; ks < 4; ++ks) {
            const f32x4 e0 = *(LAS f32x4*)(FAC + 32 * ks + 4 * hq), e1 = *(LAS f32x4*)(FAC + 32 * ks + 16 + 4 * hq);
            const f32x4 x0 = S[2 * ks] * e0, x1 = S[2 * ks + 1] * e1;
            u32x4 sb; sb.x = pg8::cvt_pk_bf16(x0[0], x0[1]); sb.y = pg8::cvt_pk_bf16(x0[2], x0[3]); sb.z = pg8::cvt_pk_bf16(x1[0], x1[1]); sb.w = pg8::cvt_pk_bf16(x1[2], x1[3]);
            const LAS bf16_t* q0 = QS + fr * 136 + 32 * ks + 4 * hq; const LAS bf16_t* q1 = q0 + 16 * 136;
            u32x4 qa0, qa1; { const u32x2 lo = *(const LAS u32x2*)q0, hi = *(const LAS u32x2*)(q0 + 16); qa0.x = lo.x; qa0.y = lo.y; qa0.z = hi.x; qa0.w = hi.y; }
            { const u32x2 lo = *(const LAS u32x2*)q1, hi = *(const LAS u32x2*)(q1 + 16); qa1.x = lo.x; qa1.y = lo.y; qa1.z = hi.x; qa1.w = hi.y; }
            o0 = __builtin_amdgcn_mfma_f32_16x16x32_bf16(__builtin_bit_cast(bf16x8, qa0), __builtin_bit_cast(bf16x8, sb), o0, 0, 0, 0);
            o1 = __builtin_amdgcn_mfma_f32_16x16x32_bf16(__builtin_bit_cast(bf16x8, qa1), __builtin_bit_cast(bf16x8, sb), o1, 0, 0, 0);
        }
        { const bf16x8 vb8 = *(const LAS bf16x8*)(vrow + 8 * hq);
#pragma unroll
          for (int dt = 0; dt < 8; ++dt) {
              const bf16x8 ka = *(const LAS bf16x8*)(KT + (16 * dt + fr) * 40 + 8 * hq);
              f32x4 t = {0.f, 0.f, 0.f, 0.f};
              t = __builtin_amdgcn_mfma_f32_16x16x32_bf16(ka, vb8, t, 0, 0, 0);
              const f32x4 el = *(LAS f32x4*)(FAC + 128 + 16 * dt + 4 * hq), er = *(LAS f32x4*)(FAC + 256 + 16 * dt + 4 * hq);
              S[dt] = S[dt] * el + er * t;
          } }
        __syncthreads();
        { u32x4 pa0, pa1, vb;
          { const LAS bf16_t* p0 = PT + fr * 40 + 4 * hq; const u32x2 lo = *(const LAS u32x2*)p0, hi = *(const LAS u32x2*)(p0 + 16); pa0.x = lo.x; pa0.y = lo.y; pa0.z = hi.x; pa0.w = hi.y; }
          { const LAS bf16_t* p1 = PT + (16 + fr) * 40 + 4 * hq; const u32x2 lo = *(const LAS u32x2*)p1, hi = *(const LAS u32x2*)(p1 + 16); pa1.x = lo.x; pa1.y = lo.y; pa1.z = hi.x; pa1.w = hi.y; }
          { const u32x2 lo = *(const LAS u32x2*)(vrow + 4 * hq), hi = *(const LAS u32x2*)(vrow + 16 + 4 * hq); vb.x = lo.x; vb.y = lo.y; vb.z = hi.x; vb.w = hi.y; }
          o0 = __builtin_amdgcn_mfma_f32_16x16x32_bf16(__builtin_bit_cast(bf16x8, pa0), __builtin_bit_cast(bf16x8, vb), o0, 0, 0, 0);
          o1 = __builtin_amdgcn_mfma_f32_16x16x32_bf16(__builtin_bit_cast(bf16x8, pa1), __builtin_bit_cast(bf16x8, vb), o1, 0, 0, 0); }
        { const int pi0 = c * 32 + 4 * hq; bf16_t* op = proj + (rowbase + (dir ? (T - 1 - pi0) : pi0)) * 7168 + 1024 * (1 + dir) + h * 128 + 16 * w + fr;
#pragma unroll
          for (int r = 0; r < 4; ++r) { op[0] = f2bf(o0[r]); op[16 * rstride] = f2bf(o1[r]); op += rstride; } }
    }
#undef HG_LOAD
    if (!sample) { float* so = p.out + (size_t)NTOK * DM + ((((size_t)b * 2 + j) * 2 + dir) * 8 + h) * 16384;
#pragma unroll
        for (int dt = 0; dt < 8; ++dt)
#pragma unroll
            for (int r = 0; r < 4; ++r) so[(16 * dt + 4 * hq + r) * 128 + 16 * w + fr] = S[dt][r];
    }
    __syncthreads();
}

template <int W> __device__ __forceinline__ void pool_prompt_unit(const Params& p, int b, int slab) {
    int tid_l = threadIdx.x; asm volatile("" : "+v"(tid_l)); const int tid = tid_l, cp = tid & 31, seg = tid >> 5; const int ch = slab * 64 + 2 * cp, t0 = seg * 16;
    const bf16_t* proj = (const bf16_t*)(p.ws + WS_PROJ); bf16_t* ycat = (bf16_t*)(p.ws + WS_YCAT);
    float xa[16 + W], xb[16 + W];
#pragma unroll
    for (int i = 0; i < 16 + W; ++i) { const int t = t0 - W / 2 + i; float a = 0.f, bq = 0.f;
        if (t >= 0 && t < 256) { const unsigned v = *(const unsigned*)(proj + ((size_t)b * 256 + t) * 7168 + 5120 + ch); a = __uint_as_float(v << 16); bq = __uint_as_float(v & 0xffff0000u); }
        xa[i] = a; xb[i] = bq; }
    unsigned gvs[16];
#pragma unroll
    for (int k = 0; k < 16; ++k) gvs[k] = *(const unsigned*)(proj + ((size_t)b * 256 + t0 + k) * 7168 + 6144 + ch);
#pragma unroll
    for (int k = 0; k < 16; ++k) { const int t = t0 + k; float sa = 0.f, sb = 0.f;
#pragma unroll
        for (int i = 0; i < W; ++i) { sa += xa[k + i]; sb += xb[k + i]; }
        const int lo = max(t - W / 2, 0), hi = min(t - W / 2 + W, 256); const float inv = __builtin_amdgcn_rcpf((float)(hi - lo));
        const size_t row = (size_t)b * 256 + t; const unsigned gv = gvs[k];
        const float ya = (sa * inv - xa[k + W / 2]) * silu_f(__uint_as_float(gv << 16)), yb = (sb * inv - xb[k + W / 2]) * silu_f(__uint_as_float(gv & 0xffff0000u));
        *(unsigned*)(ycat + row * 2048 + 1024 + ch) = pg8::cvt_pk_bf16(ya, yb); }
}
template <int W> __device__ __forceinline__ void pool_sample_unit(const Params& p, LAS unsigned char* lds, int b, int g, int slab) {
    int tid_l = threadIdx.x; asm volatile("" : "+v"(tid_l)); const int tid = tid_l; const int chb = g * 256 + slab * 16;
    const bf16_t* proj = (const bf16_t*)(p.ws + WS_PROJ); bf16_t* ycat = (bf16_t*)(p.ws + WS_YCAT);
    LAS float* buf = (LAS float*)lds;
    const size_t rowb = (size_t)NPROMPT + (size_t)b * 2048;
    { const int cp = tid & 7, col = tid >> 3; float pa[33], pb[33]; pa[0] = 0.f; pb[0] = 0.f;
#pragma unroll
      for (int r = 0; r < 32; ++r) { const unsigned v = *(const unsigned*)(proj + (rowb + r * 64 + col) * 7168 + 5120 + chb + 2 * cp);
          pa[r + 1] = pa[r] + __uint_as_float(v << 16); pb[r + 1] = pb[r] + __uint_as_float(v & 0xffff0000u); }
#pragma unroll
      for (int r = 0; r < 32; ++r) { const int lo = (r - W / 2) > 0 ? (r - W / 2) : 0, hi = (r - W / 2 + W) < 32 ? (r - W / 2 + W) : 32; const float inv = 1.f / (float)(hi - lo);
          LAS float* dst = buf + r * 1040 + col * 16 + 2 * cp; dst[0] = (pa[hi] - pa[lo]) * inv; dst[1] = (pb[hi] - pb[lo]) * inv; } }
    __syncthreads();
    { const int chl = tid & 15, r = tid >> 4; float pc[65]; pc[0] = 0.f;
#pragma unroll
      for (int col = 0; col < 64; ++col) pc[col + 1] = pc[col] + buf[r * 1040 + col * 16 + chl];
#pragma unroll
      for (int cb = 0; cb < 2; ++cb) { bf16_t zz[32], gg[32];
#pragma unroll
          for (int c2 = 0; c2 < 32; ++c2) { const size_t row = rowb + r * 64 + cb * 32 + c2; zz[c2] = proj[row * 7168 + 5120 + chb + chl]; gg[c2] = proj[row * 7168 + 6144 + chb + chl]; }
#pragma unroll
          for (int c2 = 0; c2 < 32; ++c2) { const int col = cb * 32 + c2; const int lo = (col - W / 2) > 0 ? (col - W / 2) : 0, hi = (col - W / 2 + W) < 64 ? (col - W / 2 + W) : 64; const float inv = 1.f / (float)(hi - lo);
              const size_t row = rowb + r * 64 + col;
              ycat[row * 2048 + 1024 + chb + chl] = f2bf(((pc[hi] - pc[lo]) * inv - bf2f(zz[c2])) * silu_f(bf2f(gg[c2]))); } } }
    __syncthreads();
}

__device__ __forceinline__ void pool_unit(const Params& p, LAS unsigned char* lds, int u) {
    if (u < 64) { const int b = u >> 4, g = (u >> 2) & 3, sq = u & 3;
        for (int s4 = 0; s4 < 4; ++s4) { const int slab = sq * 4 + s4;
            if (g == 0) pool_sample_unit<2>(p, lds, b, g, slab); else if (g == 1) pool_sample_unit<4>(p, lds, b, g, slab); else if (g == 2) pool_sample_unit<8>(p, lds, b, g, slab); else pool_sample_unit<16>(p, lds, b, g, slab); } }
    else { const int v = u - 64, b = v >> 4, slab = v & 15, g = slab >> 2;
        if (g == 0) pool_prompt_unit<2>(p, b, slab); else if (g == 1) pool_prompt_unit<4>(p, b, slab); else if (g == 2) pool_prompt_unit<8>(p, b, slab); else pool_prompt_unit<16>(p, b, slab); }
}
__device__ __forceinline__ void phase_mix_ab(const Params& p, int j, int l_next, LAS unsigned char* lds) {
    const int bid = blockIdx.x, G = gridDim.x;
    if (G >= 128) {
        if (bid < 64) { hgrn_unit(p, lds, j, true, bid >> 4, (bid >> 1) & 7, bid & 1); return; }
        const int idx = bid - 64, nS = G - 64;
        for (int v = idx; v < 256; v += nS) hgrn_unit(p, lds, j, false, v >> 4, (v >> 1) & 7, v & 1);
        for (int u = nS - 1 - idx; u < 320; u += nS) pool_unit(p, lds, u);
        if (l_next < 4) phase_conv(p, l_next, lds, 0, idx, nS);
        if (l_next + 1 < 4) phase_conv(p, l_next + 1, lds, 1, idx, nS);
    } else {
        for (int u = bid; u < 320; u += G) { if (u < 64) hgrn_unit(p, lds, j, true, u >> 4, (u >> 1) & 7, u & 1); else { const int v = u - 64; hgrn_unit(p, lds, j, false, v >> 4, (v >> 1) & 7, v & 1); } }
        for (int u = bid; u < 320; u += G) pool_unit(p, lds, u);
        if (l_next < 4) phase_conv(p, l_next, lds, 0, bid, G);
        if (l_next + 1 < 4) phase_conv(p, l_next + 1, lds, 1, bid, G);
    }
}
__device__ __forceinline__ void phase_combine(const Params& p, int j) {
    int tid_l = threadIdx.x; asm volatile("" : "+v"(tid_l)); const int tid = tid_l, lane = tid & 63, wv = tid >> 6; const int hd = lane >> 3, e0 = (lane & 7) * 16;
    const bf16_t* proj = (const bf16_t*)(p.ws + WS_PROJ); bf16_t* ycat = (bf16_t*)(p.ws + WS_YCAT);
    float gn[16];
#pragma unroll
    for (int i = 0; i < 16; ++i) gn[i] = p.g_onorm[j * 128 + e0 + i];
    for (int tok = blockIdx.x * 8 + wv; tok < NTOK; tok += gridDim.x * 8) {
        const bf16_t* rp = proj + (size_t)tok * 7168 + hd * 128 + e0;
        const u32x4 f0 = *(const u32x4*)(rp + 1024), f1 = *(const u32x4*)(rp + 1024 + 8), b0 = *(const u32x4*)(rp + 2048), b1 = *(const u32x4*)(rp + 2048 + 8), g0 = *(const u32x4*)(rp + 4096), g1 = *(const u32x4*)(rp + 4096 + 8);
        float s[16], gt[16]; float ss = 0.f;
#pragma unroll
        for (int i = 0; i < 4; ++i) { s[2 * i] = __uint_as_float(f0[i] << 16) + __uint_as_float(b0[i] << 16); s[2 * i + 1] = __uint_as_float(f0[i] & 0xffff0000u) + __uint_as_float(b0[i] & 0xffff0000u);
            s[8 + 2 * i] = __uint_as_float(f1[i] << 16) + __uint_as_float(b1[i] << 16); s[8 + 2 * i + 1] = __uint_as_float(f1[i] & 0xffff0000u) + __uint_as_float(b1[i] & 0xffff0000u);
            gt[2 * i] = __uint_as_float(g0[i] << 16); gt[2 * i + 1] = __uint_as_float(g0[i] & 0xffff0000u); gt[8 + 2 * i] = __uint_as_float(g1[i] << 16); gt[8 + 2 * i + 1] = __uint_as_float(g1[i] & 0xffff0000u); }
#pragma unroll
        for (int i = 0; i < 16; ++i) ss += s[i] * s[i];
        ss += __shfl_xor(ss, 1); ss += __shfl_xor(ss, 2); ss += __shfl_xor(ss, 4);
        const float r = rsqrtf(ss * (1.f / 128.f) + EPSV);
        u32x4 w0, w1;
#pragma unroll
        for (int i = 0; i < 4; ++i) { w0[i] = pg8::cvt_pk_bf16(s[2 * i] * r * gn[2 * i] * silu_f(gt[2 * i]), s[2 * i + 1] * r * gn[2 * i + 1] * silu_f(gt[2 * i + 1]));
            w1[i] = pg8::cvt_pk_bf16(s[8 + 2 * i] * r * gn[8 + 2 * i] * silu_f(gt[8 + 2 * i]), s[8 + 2 * i + 1] * r * gn[8 + 2 * i + 1] * silu_f(gt[8 + 2 * i + 1])); }
        bf16_t* yp = ycat + (size_t)tok * 2048 + hd * 128 + e0; *(u32x4*)yp = w0; *(u32x4*)(yp + 8) = w1;
    }
}

constexpr int CM_VNT = 0, CM_WS = 69632, CM_MU = 104448;
__device__ __forceinline__ void phase_mix_c(const Params& p, int j, LAS unsigned char* lds) {
    int tid_l = threadIdx.x; asm volatile("" : "+v"(tid_l)); const int tid = tid_l, lane = tid & 63, w = tid >> 6, fr = lane & 15, hq = lane >> 4;
    const bf16_t* proj = (const bf16_t*)(p.ws + WS_PROJ); bf16_t* ycat = (bf16_t*)(p.ws + WS_YCAT); const float* stats = (const float*)(p.ws + WS_STATS);
    LAS bf16_t* VNT = (LAS bf16_t*)(lds + CM_VNT); LAS bf16_t* WSL = (LAS bf16_t*)(lds + CM_WS); LAS f32x2v* MU = (LAS f32x2v*)(lds + CM_MU);
    for (int unit = blockIdx.x; unit < 768; unit += gridDim.x) {
        const int g = unit & 7, n = unit >> 3; const size_t row0 = (size_t)n * 128;
        u32x4 va[4], vb[4];
        { const int sp_ = tid >> 3, cg_ = (tid & 7) * 32; const bf16_t* s0_ = proj + (row0 + 2 * sp_) * 6144 + 2048 + g * 256 + cg_;
#pragma unroll
          for (int i = 0; i < 4; ++i) { va[i] = *(const u32x4*)(s0_ + 8 * i); vb[i] = *(const u32x4*)(s0_ + 6144 + 8 * i); } }
        if (tid < 128) { float s = 0.f, q = 0.f;
#pragma unroll
            for (int i = 0; i < 8; ++i) { const float* sp = stats + ((size_t)i * NTOK + row0 + tid) * 8; const f32x4 v = *(const f32x4*)sp, v2 = *(const f32x4*)(sp + 4); s += (v[0] + v[2]) + (v2[0] + v2[2]); q += (v[1] + v[3]) + (v2[1] + v2[3]); }
            const float mean = s * (1.f / 2048.f); const float var = fmaxf(q * (1.f / 2048.f) - mean * mean, 0.f); MU[tid] = (f32x2v){mean, rsqrtf(var + EPSV)}; }
        if (unit == (int)blockIdx.x || (gridDim.x & 7) != 0)
        { const int t = tid >> 2, s0 = (tid & 3) * 32; const float* src = p.w_sp + ((size_t)(j * 8 + g) * 128 + t) * 128 + s0;
#pragma unroll
          for (int i = 0; i < 4; ++i) { const f32x4 a = *(const f32x4*)(src + 8 * i), bq = *(const f32x4*)(src + 8 * i + 4);
              u32x4 wv; wv.x = pg8::cvt_pk_bf16(a[0], a[1]); wv.y = pg8::cvt_pk_bf16(a[2], a[3]); wv.z = pg8::cvt_pk_bf16(bq[0], bq[1]); wv.w = pg8::cvt_pk_bf16(bq[2], bq[3]);
              *(LAS u32x4*)(WSL + t * 136 + s0 + 8 * i) = wv; } }
        __syncthreads();
        { const int sp = tid >> 3, cg = (tid & 7) * 32; const f32x2v m0 = MU[2 * sp], m1 = MU[2 * sp + 1];
          const bf16_t* s0 = proj + (row0 + 2 * sp) * 6144 + 2048 + g * 256 + cg; const bf16_t* s1 = s0 + 6144;
          const float* lg = p.ln_g + j * 2048 + g * 256 + cg; const float* lb = p.ln_b + j * 2048 + g * 256 + cg;
#pragma unroll
          for (int i = 0; i < 4; ++i) { const f32x4 g0 = *(const f32x4*)(lg + 8 * i), g1 = *(const f32x4*)(lg + 8 * i + 4), b0 = *(const f32x4*)(lb + 8 * i), b1 = *(const f32x4*)(lb + 8 * i + 4);
#pragma unroll
              for (int q = 0; q < 4; ++q) { const int c = cg + 8 * i + 2 * q; const float ga = (q < 2) ? g0[2 * q] : g1[2 * q - 4], gb = (q < 2) ? g0[2 * q + 1] : g1[2 * q - 3], ba = (q < 2) ? b0[2 * q] : b1[2 * q - 4], bb = (q < 2) ? b0[2 * q + 1] : b1[2 * q - 3];
                  const float x00 = __uint_as_float(va[i][q] << 16), x01 = __uint_as_float(va[i][q] & 0xffff0000u), x10 = __uint_as_float(vb[i][q] << 16), x11 = __uint_as_float(vb[i][q] & 0xffff0000u);
                  *(LAS unsigned*)(VNT + c * 136 + 2 * sp) = pg8::cvt_pk_bf16((x00 - m0.x) * m0.y * ga + ba, (x10 - m1.x) * m1.y * ga + ba);
                  *(LAS unsigned*)(VNT + (c + 1) * 136 + 2 * sp) = pg8::cvt_pk_bf16((x01 - m0.x) * m0.y * gb + bb, (x11 - m1.x) * m1.y * gb + bb); } } }
        __syncthreads();
        bf16x8 af[2][4];
#pragma unroll
        for (int ct = 0; ct < 2; ++ct)
#pragma unroll
            for (int ks = 0; ks < 4; ++ks) af[ct][ks] = *(const LAS bf16x8*)(VNT + (32 * w + 8 * (fr >> 2) + 4 * ct + (fr & 3)) * 136 + 32 * ks + 8 * hq);
        const float* bsp = p.b_sp + (size_t)(j * 8 + g) * 128;
        f32x4 acc[8][2];
#pragma unroll
        for (int tt = 0; tt < 8; ++tt) {
            f32x4 a0 = {0.f, 0.f, 0.f, 0.f}, a1 = a0;
#pragma unroll
            for (int ks = 0; ks < 4; ++ks) { const bf16x8 bf = *(const LAS bf16x8*)(WSL + (16 * tt + fr) * 136 + 32 * ks + 8 * hq);
                a0 = __builtin_amdgcn_mfma_f32_16x16x32_bf16(af[0][ks], bf, a0, 0, 0, 0); a1 = __builtin_amdgcn_mfma_f32_16x16x32_bf16(af[1][ks], bf, a1, 0, 0, 0); }
            acc[tt][0] = a0; acc[tt][1] = a1;
        }
#pragma unroll
        for (int tb = 0; tb < 2; ++tb) {
            u32x4 uu[4], gg[4]; float bs[4]; const int c = g * 256 + 32 * w + 8 * hq;
#pragma unroll
            for (int t4 = 0; t4 < 4; ++t4) { const int tt = tb * 4 + t4; const size_t row = row0 + 16 * tt + fr; bs[t4] = bsp[16 * tt + fr];
                uu[t4] = *(const u32x4*)(proj + row * 6144 + c); gg[t4] = *(const u32x4*)(proj + row * 6144 + 4096 + c); }
#pragma unroll
            for (int t4 = 0; t4 < 4; ++t4) { const int tt = tb * 4 + t4; const size_t row = row0 + 16 * tt + fr; const float bq = bs[t4]; u32x4 o;
#pragma unroll
                for (int ct = 0; ct < 2; ++ct) { const f32x4 a = acc[tt][ct]; const unsigned ux = uu[t4][2 * ct], uy = uu[t4][2 * ct + 1], gx = gg[t4][2 * ct], gy = gg[t4][2 * ct + 1];
                    const float y0 = __uint_as_float(ux << 16) * (a[0] + bq) * silu_f(__uint_as_float(gx << 16)), y1 = __uint_as_float(ux & 0xffff0000u) * (a[1] + bq) * silu_f(__uint_as_float(gx & 0xffff0000u));
                    const float y2 = __uint_as_float(uy << 16) * (a[2] + bq) * silu_f(__uint_as_float(gy << 16)), y3 = __uint_as_float(uy & 0xffff0000u) * (a[3] + bq) * silu_f(__uint_as_float(gy & 0xffff0000u));
                    o[2 * ct] = pg8::cvt_pk_bf16(y0, y1); o[2 * ct + 1] = pg8::cvt_pk_bf16(y2, y3); }
                *(u32x4*)(ycat + row * 2048 + c) = o; }
        }
        __syncthreads();
    }
}

#ifdef DIAG_L
__device__ __forceinline__ void diag_dump_bf16(const Params& p, const bf16_t* buf, int K) {
    for (size_t i = (size_t)blockIdx.x * 512 + threadIdx.x; i < (size_t)NTOK * DM; i += (size_t)gridDim.x * 512) { float a = 0.f; for (int k = 0; k < K; ++k) a += bf2f(buf[i + (size_t)k * NTOK * DM]); p.out[i] = (float)((__float_as_uint(a) * 2654435761u) >> 16) * (1.f / 65536.f); }
}
__device__ __forceinline__ void diag_dump_f32(const Params& p, const float* buf) {
    for (size_t i = (size_t)blockIdx.x * 512 + threadIdx.x; i < (size_t)NTOK * DM; i += (size_t)gridDim.x * 512) p.out[i] = (float)((__float_as_uint(buf[i]) * 2654435761u) >> 16) * (1.f / 65536.f);
}
#endif
__global__ void __launch_bounds__(512, 2) mega_fwd(Params p) {
    extern __shared__ __attribute__((aligned(16))) unsigned char shm[];
    LAS unsigned char* lds = (LAS unsigned char*)shm;
    volatile LAS unsigned* bst = (volatile LAS unsigned*)(lds + LDS_BYTES - 16);
    if (threadIdx.x < 4) bst[threadIdx.x] = 0u;
    __syncthreads();
    XcdBarrier bar = xcd_barrier_post((unsigned*)(p.ws + WS_BAR), bst);
    phase_mod(p, lds);
    cg::this_grid().sync();
    xcd_barrier(bar);
    bf16_t* hbuf = (bf16_t*)(p.ws + WS_YCAT); bf16_t* ycat = hbuf; bf16_t* projb = (bf16_t*)(p.ws + WS_PROJ);
#ifdef DIAG_MOD
    { const float* md = (const float*)(p.ws + WS_MOD);
      for (size_t i = (size_t)blockIdx.x * 512 + threadIdx.x; i < (size_t)NTOK * DM; i += (size_t)gridDim.x * 512) p.out[i] = i < 61440 ? md[i] : 0.f;
      return; }
#endif
    for (int l = 0; l < 4; ++l) {
        const int j = l >> 1; const bool ab = (l & 1) == 0;
        phase_row(p, l);
#ifdef DIAG_STOP_LAYER
        if (l == DIAG_STOP_LAYER) {
#ifdef DIAG_BITS
            xcd_barrier(bar);
            for (size_t i = (size_t)blockIdx.x * 512 + threadIdx.x; i < (size_t)NTOK * DM; i += (size_t)gridDim.x * 512) { const unsigned u = __float_as_uint(p.out[i]); p.out[i] = (float)((u * 2654435761u) >> 16) * (1.f / 65536.f); }
#endif
#ifdef DIAG_MOD2
            xcd_barrier(bar);
            { const float* md = (const float*)(p.ws + WS_MOD);
              for (size_t i = (size_t)blockIdx.x * 512 + threadIdx.x; i < (size_t)NTOK * DM; i += (size_t)gridDim.x * 512) p.out[i] = i < 61440 ? md[i] : 0.f; }
#endif
            return; }
#endif
        if (l == 0) phase_conv(p, 0, lds, 0, (int)blockIdx.x, (int)gridDim.x);
        else if (l == 2) phase_conv(p, 2, lds, 2, (int)blockIdx.x, (int)gridDim.x);
        xcd_barrier(bar);
#ifdef DIAG_L
        if (l == DIAG_L && DIAG_S == 0) { unsigned* hb = (unsigned*)hbuf;
            for (size_t i = (size_t)blockIdx.x * 512 + threadIdx.x; i < (size_t)NTOK * DM / 2; i += (size_t)gridDim.x * 512) { const unsigned v = __hip_atomic_load(hb + i, __ATOMIC_RELAXED, __HIP_MEMORY_SCOPE_AGENT);
                p.out[2 * i] = __uint_as_float(v << 16); p.out[2 * i + 1] = __uint_as_float(v & 0xffff0000u); }
            return; }
#endif
        { pg8::StaticOrder S; pg8::Gemm g; g.A = hbuf; g.Bt = (const bf16_t*)(p.ws + ws_win(l)); g.M = NTOK; g.K = 1024;
          if (ab) { g.N = 7168; S.init(g.M, g.N, (int)gridDim.x, (int)blockIdx.x); pg8::EpiBf16S E; E.O = projb; E.ldc = 7168; E.stats = nullptr; E.st_lo = 0; E.st_hi = 0; E.sl_hi = 4; E.kg_hi = 12; E.lbp = (const float*)(p.ws + WS_LB) + j * 2048;
              pg8::gemm_phase<pg8::EpiBf16S, pg8::StaticOrder, false>(lds, g, S, E, nullptr); }
          else { g.N = 6144; S.init(g.M, g.N, (int)gridDim.x, (int)blockIdx.x); pg8::EpiBf16S E; E.O = projb; E.ldc = 6144; E.stats = (float*)(p.ws + WS_STATS); E.st_lo = 8; E.st_hi = 16; E.sl_hi = 0; E.kg_hi = 0; E.lbp = nullptr;
              pg8::gemm_phase<pg8::EpiBf16S, pg8::StaticOrder, false>(lds, g, S, E, nullptr); } }
        xcd_barrier(bar);
#ifdef DIAG_L
        if (l == DIAG_L && DIAG_S == 1) { diag_dump_bf16(p, projb, ab ? 7 : 6); return; }
#endif
        if (ab) { phase_mix_ab(p, j, l + 1, lds); xcd_barrier(bar); phase_combine(p, j); }
        else phase_mix_c(p, j, lds);
        xcd_barrier(bar);
#ifdef DIAG_L
        if (l == DIAG_L && DIAG_S == 2) { diag_dump_bf16(p, ycat, 2); return; }
        if (l == DIAG_L && DIAG_S == 4) {
            for (size_t i = (size_t)blockIdx.x * 512 + threadIdx.x; i < (size_t)NTOK * DM; i += (size_t)gridDim.x * 512) { const size_t rr = i >> 10; const float a = (rr >= DIAG_R0 && rr < DIAG_R1) ? bf2f(ycat[rr * 2048 + (i & 1023) + DIAG_HALF * 1024]) : 0.f;
                p.out[i] = (float)((__float_as_uint(a) * 2654435761u) >> 16) * (1.f / 65536.f); }
            return; }
#endif
        { pg8::StaticOrder S; pg8::Gemm g; g.A = ycat; g.Bt = (const bf16_t*)(p.ws + ws_wout(l)); g.M = NTOK; g.N = 1024; g.K = 2048; S.init(g.M, g.N, (int)gridDim.x, (int)blockIdx.x);
          pg8::EpiBf16S E; E.O = projb; E.ldc = 1024; E.stats = nullptr; E.st_lo = 0; E.st_hi = 0; E.sl_hi = 0; E.kg_hi = 0; E.lbp = nullptr;
          pg8::gemm_phase<pg8::EpiBf16S, pg8::StaticOrder, false>(lds, g, S, E, nullptr); }
        xcd_barrier(bar);
#ifdef DIAG_L
        if (l == DIAG_L && DIAG_S == 3) { diag_dump_f32(p, (const float*)(p.ws + WS_PROJ)); return; }
#endif
    }
    phase_row(p, 4);
}

extern "C" void kernel_launch(void* const* d_in, const int* in_sizes, int n_in, void* d_out, int out_size, void* d_ws, size_t ws_size, hipStream_t stream) {
    static int grid = 0;
    if (grid == 0) {
        if (n_in != 21 || ws_size < WS_END) { fprintf(stderr, "kernel_launch: unexpected n_in %d / ws_size %zu (need %zu)\n", n_in, ws_size, (size_t)WS_END); grid = -1; return; }
        int dev = 0, cus = 0, per_cu = 0;
        hipGetDevice(&dev); hipDeviceGetAttribute(&cus, hipDeviceAttributeMultiprocessorCount, dev);
        if (hipFuncSetAttribute((const void*)mega_fwd, hipFuncAttributeMaxDynamicSharedMemorySize, LDS_BYTES) != hipSuccess) { fprintf(stderr, "kernel_launch: hipFuncSetAttribute failed\n"); grid = -1; return; }
        hipOccupancyMaxActiveBlocksPerMultiprocessor(&per_cu, (const void*)mega_fwd, 512, LDS_BYTES);
        (void)hipGetLastError();
        if (per_cu < 1) { fprintf(stderr, "kernel_launch: occupancy query says %d blocks per CU\n", per_cu); }
        grid = cus;
    }
    if (grid < 0) return;
    hipMemsetAsync((char*)d_ws + WS_BAR, 0, 16384, stream);
    Params p{};
    p.x_prompt = (const float*)d_in[0]; p.x_sample = (const float*)d_in[1]; p.c = (const float*)d_in[2]; p.state_hgrn = (const float*)d_in[3]; p.c_ctx = (const float*)d_in[4];
    p.w_ada = (const float*)d_in[5]; p.b_ada = (const float*)d_in[6]; p.g_pre = (const float*)d_in[7]; p.g_post = (const float*)d_in[8]; p.w_in_ab = (const float*)d_in[9];
    p.w_out_ab = (const float*)d_in[10]; p.lb_logits = (const float*)d_in[11]; p.g_onorm = (const float*)d_in[12]; p.w_pool = (const float*)d_in[13]; p.pool_scale = (const float*)d_in[14];
    p.w_in_c = (const float*)d_in[15]; p.w_out_c = (const float*)d_in[16]; p.ln_g = (const float*)d_in[17]; p.ln_b = (const float*)d_in[18]; p.w_sp = (const float*)d_in[19]; p.b_sp = (const float*)d_in[20];
    p.out = (float*)d_out; p.ws = (unsigned char*)d_ws;
    void* args[] = {&p};
    hipError_t e = hipLaunchCooperativeKernel((const void*)mega_fwd, dim3(grid), dim3(512), args, LDS_BYTES, stream);
    if (e != hipSuccess) fprintf(stderr, "kernel_launch: cooperative launch failed: %s (grid %d)\n", hipGetErrorString(e), grid);
}
```

```cpp
#include <hip/hip_runtime.h>
#include <hip/hip_cooperative_groups.h>
#include <cstdio>
namespace cg = cooperative_groups;
namespace pg8 {
#define PG8_LAS __attribute__((address_space(3)))
typedef unsigned short bf16_t;
typedef short bf16x8 __attribute__((ext_vector_type(8)));
typedef float f32x4 __attribute__((ext_vector_type(4)));
typedef unsigned u32x4 __attribute__((ext_vector_type(4)));
constexpr int BM = 256, BK = 64, HALF = 128, HTB = HALF * BK * 2  , STAGE_BYTES = 8 * HTB, NXCD = 8, WGM = 8;

__host__ __device__ __forceinline__ int lds_byte(int r, int c) { const int st = (r >> 4) * 2 + (c >> 5), rr = r & 15, cc = c & 31, ob = rr * 64 + cc * 2; return st * 1024 + (ob ^ (((ob >> 9) & 1) << 5)); }
__host__ __device__ __forceinline__ void stage_rc(int b, int& R, int& C) { const int st = b / 1024, sb = b % 1024, swz = sb ^ (((sb >> 9) & 1) << 5); R = (st >> 1) * 16 + swz / 64; C = (st & 1) * 32 + (swz % 64) / 2; }
__host__ __device__ __forceinline__ int perm32(int rho) { const int n = rho >> 4, i = rho & 15; return 8 * (i >> 2) + 4 * n + (i & 3); }

struct Unit { int pm, pn; };
struct Gemm { const bf16_t* A; const bf16_t* Bt; int M, N, K; };

struct StaticOrder {
    int nM, nN, nwg, G, c;
    __host__ __device__ void init(int M, int N, int G_, int c_) { nM = M / BM; nN = N / BM; nwg = nM * nN; G = G_; c = c_; }
    __host__ __device__ bool next(int i, Unit& u) const {
        const long L = (long)i * G + c; if (L >= nwg) return false;
        int wgid = (int)L; { const int q = nwg / NXCD, r = nwg % NXCD, xcd = wgid % NXCD, off = wgid / NXCD; wgid = (xcd < r ? xcd * (q + 1) : r * (q + 1) + (xcd - r) * q) + off; }
        const int nig = WGM * nN, gid = wgid / nig, fm = gid * WGM, gsz = (nM - fm) < WGM ? (nM - fm) : WGM;
        u.pm = fm + ((wgid % nig) % gsz); u.pn = (wgid % nig) / gsz; return true;
    }
    __device__ __forceinline__ void a_ready(const Unit&) const {}
    __device__ __forceinline__ void done(const Unit&) const {}
};
__device__ __forceinline__ unsigned cvt_pk_bf16(float lo, float hi) { unsigned r; asm volatile("v_cvt_pk_bf16_f32 %0, %1, %2\n\ts_nop 1" : "=v"(r) : "v"(lo), "v"(hi)); return r; }
typedef float f32x2 __attribute__((ext_vector_type(2)));
struct EpiF32 {
    static constexpr bool PERM = false, AFTER_DRAIN = false;
    float* C; int ldc;
    __device__ __forceinline__ void operator()(const f32x4 (&acc)[2][2][4][2], const Unit& u, int wr, int wc, int fr, int fq) const {
        const int row0 = u.pm * BM + wr * 64 + fr, col0 = u.pn * BM + wc * 32 + 4 * fq;
#pragma unroll
        for (int ai = 0; ai < 2; ++ai)
#pragma unroll
            for (int m = 0; m < 4; ++m) { float* rowp = C + (size_t)(row0 + ai * HALF + m * 16) * ldc + col0;
#pragma unroll
                for (int bj = 0; bj < 2; ++bj)
#pragma unroll
                    for (int n = 0; n < 2; ++n) *(f32x4*)(rowp + bj * HALF + n * 16) = acc[ai][bj][m][n]; }
    }
};
struct EpiBf16S {
    static constexpr bool PERM = true, AFTER_DRAIN = false;
    bf16_t* O; int ldc; float* stats; int st_lo, st_hi; int sl_hi; const float* lbp; int kg_hi;
    __device__ __forceinline__ void operator()(const f32x4 (&acc)[2][2][4][2], const Unit& u, int wr, int wc, int fr, int fq) const {
        const int row0 = u.pm * BM + wr * 64 + fr; const int col0 = u.pn * BM + wc * 32 + 8 * fq;
        const bool dost = (stats != nullptr) && u.pn >= st_lo && u.pn < st_hi;
        const bool dosl = u.pn < sl_hi; const bool dokg = u.pn >= sl_hi && u.pn < kg_hi;
#pragma unroll
        for (int ai = 0; ai < 2; ++ai)
#pragma unroll
            for (int m = 0; m < 4; ++m) { const int row = row0 + ai * HALF + m * 16; bf16_t* rowp = O + (size_t)row * ldc + col0; float s = 0.f, q = 0.f;
#pragma unroll
                for (int bj = 0; bj < 2; ++bj) { f32x4 v0 = acc[ai][bj][m][0] + 0.f, v1 = acc[ai][bj][m][1] + 0.f;
                    if (dokg) { const float* lq = lbp + (col0 + bj * HALF - 256 * sl_hi); const f32x4 l0 = *(const f32x4*)lq, l1 = *(const f32x4*)(lq + 4);
#pragma unroll
                        for (int q4 = 0; q4 < 4; ++q4) { v0[q4] = (1.f - l0[q4]) * __builtin_amdgcn_rcpf(1.f + __expf(v0[q4])); v1[q4] = (1.f - l1[q4]) * __builtin_amdgcn_rcpf(1.f + __expf(v1[q4])); } }
                    if (dosl) {
#pragma unroll
                        for (int q4 = 0; q4 < 4; ++q4) { v0[q4] = v0[q4] * __builtin_amdgcn_rcpf(1.f + __expf(-v0[q4])); v1[q4] = v1[q4] * __builtin_amdgcn_rcpf(1.f + __expf(-v1[q4])); } }
                    u32x4 w; w.x = cvt_pk_bf16(v0[0], v0[1]); w.y = cvt_pk_bf16(v0[2], v0[3]); w.z = cvt_pk_bf16(v1[0], v1[1]); w.w = cvt_pk_bf16(v1[2], v1[3]);
                    *(u32x4*)(rowp + bj * HALF) = w;
                    s += (v0[0] + v0[1]) + (v0[2] + v0[3]) + (v1[0] + v1[1]) + (v1[2] + v1[3]);
                    q += (v0[0] * v0[0] + v0[1] * v0[1]) + (v0[2] * v0[2] + v0[3] * v0[3]) + (v1[0] * v1[0] + v1[1] * v1[1]) + (v1[2] * v1[2] + v1[3] * v1[3]); }
                if (dost) { s += __shfl_xor(s, 16); s += __shfl_xor(s, 32); q += __shfl_xor(q, 16); q += __shfl_xor(q, 32);
                    if (fq == 0) { float* sp = stats + (((size_t)(u.pn - st_lo) * 12288 + row) * 4 + wc) * 2; sp[0] = s; sp[1] = q; } } }
    }
};
template <class Epi, class Sched, bool STAMP = false>
__device__ __forceinline__ void gemm_phase(PG8_LAS unsigned char* lds, const Gemm g, const Sched& S, const Epi& E, unsigned long long* stamps) {
    int tid_l = threadIdx.x; asm volatile("" : "+v"(tid_l));
    const int tid = tid_l, wid = __builtin_amdgcn_readfirstlane(tid >> 6), lane = tid & 63, wr = wid >> 2, wc = wid & 3, fr = lane & 15, fq = lane >> 4;
    const int K = g.K, nt = K / BK;
    int ts_lo = 0, ts_hi = 0, nts = 0; const unsigned long long rt_entry = STAMP ? (unsigned long long)wall_clock64() : 0ull;
#define PG8_STAMP() do { if (STAMP && wid == 0 && nts < 64) { const unsigned long long _c = (unsigned long long)clock64(); \
        ts_lo = (lane == nts) ? (int)(unsigned)_c : ts_lo; ts_hi = (lane == nts) ? (int)(unsigned)(_c >> 32) : ts_hi; ++nts; } } while (0)
    PG8_STAMP();
    unsigned voffA[2], voffB[2];
#pragma unroll
    for (int i = 0; i < 2; ++i) { int R, C; stage_rc(tid * 16 + i * 8192, R, C); const int Rb = Epi::PERM ? ((R & ~31) + perm32(R & 31)) : R;
        voffA[i] = (unsigned)(R * K + C) * 2u; voffB[i] = (unsigned)(Rb * K + C) * 2u; }
    const size_t kstep = (size_t)(BK * 2);
    const size_t hstep = (size_t)HALF * K * 2;
    const size_t tstep = 2 * hstep;
    const unsigned ldsw = (unsigned)wid * 1024u;
    const int aoff = lds_byte(wr * 64 + fr, fq * 8), boff = lds_byte(wc * 32 + fr, fq * 8);
#define PG8_SA(b, h) (((b) * 2 + (h)) * HTB)
#define PG8_SB(b, h) ((4 + (b) * 2 + (h)) * HTB)
#define PG8_STAGE(bufoff, gbase, voff) do { _Pragma("unroll") for (int _i = 0; _i < 2; ++_i) \
        __builtin_amdgcn_global_load_lds((const unsigned*)((const char*)(gbase) + (voff)[_i]), (PG8_LAS unsigned*)(lds + (bufoff) + ldsw + _i * 8192), 16, 0, 0); } while (0)
#define PG8_LDA(dst, b, h) do { _Pragma("unroll") for (int m = 0; m < 4; ++m) _Pragma("unroll") for (int k = 0; k < 2; ++k) dst[m][k] = *(const PG8_LAS bf16x8*)(lds + PG8_SA(b, h) + aoff + m * 2048 + k * 1024); } while (0)
#define PG8_LDB(dst, b, h) do { _Pragma("unroll") for (int n = 0; n < 2; ++n) _Pragma("unroll") for (int k = 0; k < 2; ++k) dst[n][k] = *(const PG8_LAS bf16x8*)(lds + PG8_SB(b, h) + boff + n * 2048 + k * 1024); } while (0)
#define PG8_MMA(ai, bj, At, Bt) do { __builtin_amdgcn_s_setprio(1); _Pragma("unroll") for (int m = 0; m < 4; ++m) _Pragma("unroll") for (int n = 0; n < 2; ++n) _Pragma("unroll") for (int k = 0; k < 2; ++k) \
        acc[ai][bj][m][n] = __builtin_amdgcn_mfma_f32_16x16x32_bf16(Bt[n][k], At[m][k], acc[ai][bj][m][n], 0, 0, 0); __builtin_amdgcn_s_setprio(0); } while (0)
#define PG8_WAIT_V(n) asm volatile("s_waitcnt vmcnt(" #n ")" ::: "memory")
#define PG8_WAIT_L(n) asm volatile("s_waitcnt lgkmcnt(" #n ")" ::: "memory")
#define PG8_BAR __builtin_amdgcn_s_barrier()
#define PG8_SCHED __builtin_amdgcn_sched_barrier(0)
    Unit cur, nxt; int ui = 0;
    if (!S.next(0, cur)) return;
    f32x4 acc[2][2][4][2];
#pragma unroll
    for (int a = 0; a < 2; ++a)
#pragma unroll
        for (int b = 0; b < 2; ++b)
#pragma unroll
            for (int m = 0; m < 4; ++m)
#pragma unroll
                for (int n = 0; n < 2; ++n) acc[a][b][m][n] = (f32x4){0.f, 0.f, 0.f, 0.f};
    bf16x8 At[4][2], B0[2][2], B1[2][2];
    const char* cA = (const char*)g.A + (size_t)cur.pm * tstep; const char* cB = (const char*)g.Bt + (size_t)cur.pn * tstep;
    S.a_ready(cur);
    PG8_STAGE(PG8_SB(0, 0), cB, voffB); PG8_STAGE(PG8_SA(0, 0), cA, voffA); PG8_STAGE(PG8_SB(0, 1), cB + hstep, voffB); PG8_STAGE(PG8_SA(0, 1), cA + hstep, voffA);
    if (wr == 1) PG8_BAR;
    PG8_WAIT_V(4); PG8_BAR;
    PG8_STAGE(PG8_SB(1, 0), cB + kstep, voffB); PG8_STAGE(PG8_SA(1, 0), cA + kstep, voffA); PG8_STAGE(PG8_SB(1, 1), cB + hstep + kstep, voffB);
    PG8_WAIT_V(6); PG8_BAR;
    PG8_STAMP();
    for (;;) {
        const bool has_next = S.next(ui + 1, nxt);
        const char* nA = has_next ? (const char*)g.A + (size_t)nxt.pm * tstep : cA; const char* nB = has_next ? (const char*)g.Bt + (size_t)nxt.pn * tstep : cB;
        for (int t = 0; t < nt; t += 2) {
            const bool last = (t == nt - 2);
            const char* a1 = cA + (size_t)(t + 1) * kstep;
            const char* a2 = last ? nA : cA + (size_t)(t + 2) * kstep; const char* b2 = last ? nB : cB + (size_t)(t + 2) * kstep;
            const char* a3 = a2 + kstep; const char* b3 = b2 + kstep;
            if (last && has_next) S.a_ready(nxt);
            PG8_LDB(B0, 0, 0); PG8_SCHED; PG8_LDA(At, 0, 0); PG8_STAGE(PG8_SA(1, 1), a1 + hstep, voffA);
            PG8_WAIT_L(8); PG8_BAR; PG8_WAIT_L(0); PG8_MMA(0, 0, At, B0); PG8_BAR; PG8_SCHED;
            PG8_LDB(B1, 0, 1); PG8_STAGE(PG8_SB(0, 0), b2, voffB);
            PG8_BAR; PG8_WAIT_L(0); PG8_MMA(0, 1, At, B1); PG8_BAR;
            PG8_LDA(At, 0, 1); PG8_STAGE(PG8_SA(0, 0), a2, voffA);
            PG8_BAR; PG8_WAIT_L(0); PG8_MMA(1, 0, At, B0); PG8_BAR; PG8_SCHED;
            PG8_STAGE(PG8_SB(0, 1), b2 + hstep, voffB);
            PG8_WAIT_V(6); PG8_BAR; PG8_MMA(1, 1, At, B1); PG8_BAR;
            PG8_LDB(B0, 1, 0); PG8_SCHED; PG8_LDA(At, 1, 0); PG8_STAGE(PG8_SA(0, 1), a2 + hstep, voffA);
            PG8_WAIT_L(8); PG8_BAR; PG8_WAIT_L(0); PG8_MMA(0, 0, At, B0); PG8_BAR; PG8_SCHED;
            PG8_LDB(B1, 1, 1); PG8_STAGE(PG8_SB(1, 0), b3, voffB);
            PG8_BAR; PG8_WAIT_L(0); PG8_MMA(0, 1, At, B1); PG8_BAR;
            PG8_LDA(At, 1, 1); PG8_STAGE(PG8_SA(1, 0), a3, voffA);
            PG8_BAR; PG8_WAIT_L(0); PG8_MMA(1, 0, At, B0); PG8_BAR; PG8_SCHED;
            PG8_STAGE(PG8_SB(1, 1), b3 + hstep, voffB);
            PG8_WAIT_V(6); PG8_BAR; PG8_MMA(1, 1, At, B1); PG8_BAR;
        }
        PG8_STAMP();
        if constexpr (!Epi::AFTER_DRAIN) { E(acc, cur, wr, wc, fr, fq); S.done(cur); }
        PG8_STAMP();
        if (!has_next) break;
#pragma unroll
        for (int a = 0; a < 2; ++a)
#pragma unroll
            for (int b = 0; b < 2; ++b)
#pragma unroll
                for (int m = 0; m < 4; ++m)
#pragma unroll
                    for (int n = 0; n < 2; ++n) acc[a][b][m][n] = (f32x4){0.f, 0.f, 0.f, 0.f};
        cur = nxt; cA = nA; cB = nB; ++ui;
    }
    PG8_WAIT_V(0);
    if (wr == 0) PG8_BAR;
    PG8_BAR;
    if constexpr (Epi::AFTER_DRAIN) { E.fused(acc, cur, wr, wc, fr, fq, lds, wid, lane); S.done(cur); }
    PG8_STAMP();
    if (STAMP && wid == 0) { stamps[lane] = lane < nts ? (((unsigned long long)(unsigned)ts_hi << 32) | (unsigned)ts_lo) : 0ull;
        if (lane == 62) stamps[62] = rt_entry; if (lane == 63) stamps[63] = (unsigned long long)wall_clock64(); }
#undef PG8_STAMP
#undef PG8_SA
#undef PG8_SB
#undef PG8_STAGE
#undef PG8_LDA
#undef PG8_LDB
#undef PG8_MMA
#undef PG8_WAIT_V
#undef PG8_WAIT_L
#undef PG8_BAR
#undef PG8_SCHED
}
}

#define LAS __attribute__((address_space(3)))
using pg8::bf16_t; using pg8::bf16x8; using pg8::f32x4; using pg8::u32x4;
typedef short bf16x4 __attribute__((ext_vector_type(4)));
typedef unsigned u32x2 __attribute__((ext_vector_type(2)));
typedef float f32x2v __attribute__((ext_vector_type(2)));
constexpr int NTOK = 12288, NPROMPT = 4096, DM = 1024;
constexpr int LDS_BYTES = 147456;
constexpr float EPSV = 1e-6f;
constexpr size_t WS_PROJ = 0;
constexpr size_t WS_YCAT = 176160768;
constexpr size_t WS_WIN  = WS_YCAT + 50331648;
constexpr size_t WS_WOUT = WS_WIN + 14680064;
constexpr size_t WS_STATS = WS_WOUT + 4194304;
constexpr size_t WS_MOD = WS_STATS + 3145728;
constexpr size_t WS_LB = WS_MOD + 245760;
constexpr size_t WS_BAR = WS_LB + 16384;
constexpr size_t WS_WIN2 = WS_BAR + 16384;
constexpr size_t WS_WOUT2 = WS_WIN2 + 14680064;
constexpr size_t WS_END = WS_WOUT2 + 4194304;
__device__ __forceinline__ size_t ws_win(int l) { return (l & 1) ? WS_WIN2 : WS_WIN; }
__device__ __forceinline__ size_t ws_wout(int l) { return (l & 1) ? WS_WOUT2 : WS_WOUT; }

struct Params {
    const float *x_prompt, *x_sample, *c, *state_hgrn, *c_ctx, *w_ada, *b_ada, *g_pre, *g_post, *w_in_ab, *w_out_ab, *lb_logits, *g_onorm, *w_pool, *pool_scale,
        *w_in_c, *w_out_c, *ln_g, *ln_b, *w_sp, *b_sp;
    float* out; unsigned char* ws;
};

__device__ __forceinline__ float bf2f(bf16_t b) { return __uint_as_float(((unsigned)b) << 16); }
__device__ __forceinline__ bf16_t f2bf(float f) { unsigned u = __float_as_uint(f); u += 0x7FFFu + ((u >> 16) & 1u); return (bf16_t)(u >> 16); }
__device__ __forceinline__ float silu_f(float x) { return x * __builtin_amdgcn_rcpf(1.f + __expf(-x)); }
__device__ __forceinline__ float wave_sum(float v) { v += __shfl_xor(v, 1); v += __shfl_xor(v, 2); v += __shfl_xor(v, 4); v += __shfl_xor(v, 8); v += __shfl_xor(v, 16); v += __shfl_xor(v, 32); return v; }

#define XB_TMO      128
#define XB_XCNT(j)  (256  + 64 * (j))
#define XB_XSUB(j)  (1280 + 64 * (j))
#define XB_XGEN(j)  (2304 + 64 * (j))
#define XB_TOP      3328
#define XB_TOPGEN   3392
#define XCD_BAR_WORDS 3456
#define XB_SPIN_CAP (1u << 20)
__device__ __forceinline__ unsigned xb_ld(unsigned* p)              { return __hip_atomic_load(p, __ATOMIC_RELAXED, __HIP_MEMORY_SCOPE_AGENT); }
__device__ __forceinline__ unsigned xb_add(unsigned* p, unsigned v) { return __hip_atomic_fetch_add(p, v, __ATOMIC_RELAXED, __HIP_MEMORY_SCOPE_AGENT); }
__device__ __forceinline__ unsigned xb_xcc_id() { return (unsigned)__builtin_amdgcn_s_getreg((3 << 11) | 20) & 0xFu; }
#define XB_SPIN(cond, bar) do { unsigned _sp = 0; while (cond) { __builtin_amdgcn_s_sleep(1); \
    if ((++_sp & 255u) == 0u) { if (xb_ld(&(bar)[XB_TMO])) break; if (_sp > XB_SPIN_CAP) { atomicAdd(&(bar)[XB_TMO], 1u); break; } } } } while (0)
struct XcdBarrier { unsigned* bar; unsigned x; volatile LAS unsigned* st; };
__device__ __forceinline__ XcdBarrier xcd_barrier_post(unsigned* bar, volatile LAS unsigned* st) {
    XcdBarrier b; b.bar = bar; b.x = xb_xcc_id(); b.st = st;
    if (threadIdx.x == 0) (void)xb_add(&bar[XB_XCNT(b.x)], 1u);
    return b;
}
__device__ __forceinline__ void xcd_barrier_complete(unsigned* bar, unsigned x, unsigned& nloc, unsigned& nx) {
    const unsigned G = gridDim.x * gridDim.y * gridDim.z;
    unsigned sum, cnt, mine, sp = 0u;
    for (;;) {
        sum = 0u; cnt = 0u; mine = 0u;
#pragma unroll
        for (unsigned j = 0; j < 16; ++j) { const unsigned c = xb_ld(&bar[XB_XCNT(j)]); sum += c; cnt += (c > 0u) ? 1u : 0u; mine = (j == x) ? c : mine; }
        if (sum == G) break;
        __builtin_amdgcn_s_sleep(1);
        if ((++sp & 255u) == 0u) { if (xb_ld(&bar[XB_TMO])) break; if (sp > XB_SPIN_CAP) { atomicAdd(&bar[XB_TMO], 1u); break; } }
    }
    nloc = mine > 0u ? mine : 1u; nx = cnt > 0u ? cnt : 1u;
}
__device__ __forceinline__ void xcd_barrier(const XcdBarrier& b) {
    asm volatile("s_waitcnt vmcnt(0)" ::: "memory");
    __syncthreads();
    if (threadIdx.x == 0) {
        unsigned* bar = b.bar;
        __builtin_amdgcn_s_waitcnt(0);
        unsigned nloc = b.st[0], nx = b.st[1];
        if (nloc == 0u) { xcd_barrier_complete(bar, b.x, nloc, nx); b.st[0] = nloc; b.st[1] = nx; }
        const unsigned old = xb_add(&bar[XB_XSUB(b.x)], 1u);
        const unsigned gen = old / nloc;
        if (old + 1u == (gen + 1u) * nloc) {
            __builtin_amdgcn_fence(__ATOMIC_RELEASE, "agent");
            asm volatile("s_waitcnt vmcnt(0)" ::: "memory");
            const unsigned og = xb_add(&bar[XB_TOP], 1u);
            const unsigned tg = og / nx;
            if (og + 1u == (tg + 1u) * nx) xb_add(&bar[XB_TOPGEN], 1u);
            else XB_SPIN(xb_ld(&bar[XB_TOPGEN]) == tg, bar);
            __builtin_amdgcn_fence(__ATOMIC_ACQUIRE, "agent");
            xb_add(&bar[XB_XGEN(b.x)], 1u);
            asm volatile("s_waitcnt vmcnt(0)" ::: "memory");
        } else {
            XB_SPIN(xb_ld(&bar[XB_XGEN(b.x)]) == gen, bar);
            __builtin_amdgcn_fence(__ATOMIC_ACQUIRE, "agent");
            asm volatile("s_waitcnt vmcnt(0)" ::: "memory");
        }
    }
    __syncthreads();
}

__device__ __forceinline__ void phase_mod(const Params& p, LAS unsigned char* lds) {
    int tid_l = threadIdx.x; asm volatile("" : "+v"(tid_l)); const int tid = tid_l;
    LAS float* sc = (LAS float*)lds;
    LAS float* red = sc + 5 * 1024;
    for (int i = tid; i < 5 * 1024; i += 512) { const int n = i >> 10, k = i & 1023; const float v = (n == 0) ? p.c_ctx[k] : p.c[(n - 1) * 1024 + k]; sc[i] = silu_f(v); }
    __syncthreads();
    float* mod = (float*)(p.ws + WS_MOD);
    for (int unit = blockIdx.x; unit < 192; unit += gridDim.x) {
        const int l = unit / 48, c0 = (unit % 48) * 64, cc = tid & 63, ks = tid >> 6;
        const float* w = p.w_ada + (size_t)l * 1024 * 3072 + c0 + cc;
        float a0 = 0.f, a1 = 0.f, a2 = 0.f, a3 = 0.f, a4 = 0.f;
#pragma unroll 8
        for (int k = ks * 128; k < ks * 128 + 128; ++k) { const float wv = __builtin_nontemporal_load(w + (size_t)k * 3072);
            a0 += sc[k] * wv; a1 += sc[1024 + k] * wv; a2 += sc[2048 + k] * wv; a3 += sc[3072 + k] * wv; a4 += sc[4096 + k] * wv; }
        LAS float* r = red + (ks * 64 + cc) * 5; r[0] = a0; r[1] = a1; r[2] = a2; r[3] = a3; r[4] = a4;
        __syncthreads();
        if (tid < 320) { const int c2 = tid & 63, n = tid >> 6; float s = 0.f;
#pragma unroll
            for (int k8 = 0; k8 < 8; ++k8) s += red[(k8 * 64 + c2) * 5 + n];
            mod[(size_t)(l * 5 + n) * 3072 + c0 + c2] = s + p.b_ada[l * 3072 + c0 + c2]; }
        __syncthreads();
    }
    float* LB = (float*)(p.ws + WS_LB);
    for (int i = blockIdx.x * 512 + tid; i < 2048; i += gridDim.x * 512) { const float l0 = p.lb_logits[i], l1 = p.lb_logits[2048 + i];
        LB[i] = 0.f; LB[2048 + i] = 1.f / (1.f + __expf(l0 - l1)); }
}

__device__ __forceinline__ void phase_row(const Params& p, int l) {
    int tid_l = threadIdx.x; asm volatile("" : "+v"(tid_l)); const int tid = tid_l, lane = tid & 63, wv = tid >> 6;
    const float* mod = (const float*)(p.ws + WS_MOD);
    const bf16_t* ybuf = (const bf16_t*)(p.ws + WS_PROJ);
    bf16_t* hbuf = (bf16_t*)(p.ws + WS_YCAT);
    const int rstep = gridDim.x * 8;
    for (int row0 = blockIdx.x * 8 + wv; row0 < NTOK; row0 += 2 * rstep) {
        int rows[2]; rows[0] = row0; rows[1] = (row0 + rstep < NTOK) ? row0 + rstep : row0;
        int nn[2]; f32x4 x[2][4], y[2][4];
#pragma unroll
        for (int q = 0; q < 2; ++q) { const int row = rows[q]; nn[q] = row < NPROMPT ? 0 : 1 + ((row - NPROMPT) >> 11);
            const float* xsrc = (l == 0) ? (row < NPROMPT ? p.x_prompt + (size_t)row * DM : p.x_sample + (size_t)(row - NPROMPT) * DM) : p.out + (size_t)row * DM;
#pragma unroll
            for (int i = 0; i < 4; ++i) x[q][i] = (l == 0) ? __builtin_nontemporal_load((const f32x4*)(xsrc + (i * 64 + lane) * 4)) : *(const f32x4*)(xsrc + (i * 64 + lane) * 4);
            if (l > 0) {
#pragma unroll
                for (int i = 0; i < 4; ++i) { const u32x2 yv = *(const u32x2*)(ybuf + (size_t)row * DM + (i * 64 + lane) * 4);
                    y[q][i] = (f32x4){__uint_as_float(yv.x << 16), __uint_as_float(yv.x & 0xffff0000u), __uint_as_float(yv.y << 16), __uint_as_float(yv.y & 0xffff0000u)}; } } }
        if (l > 0) {
            float ss[2];
#pragma unroll
            for (int q = 0; q < 2; ++q) { ss[q] = 0.f;
#pragma unroll
                for (int i = 0; i < 4; ++i) ss[q] += y[q][i][0] * y[q][i][0] + y[q][i][1] * y[q][i][1] + y[q][i][2] * y[q][i][2] + y[q][i][3] * y[q][i][3]; }
            ss[0] = wave_sum(ss[0]); ss[1] = wave_sum(ss[1]);
            const float* gp = p.g_post + (l - 1) * 1024;
#pragma unroll
            for (int q = 0; q < 2; ++q) { const float r = rsqrtf(ss[q] * (1.f / 1024.f) + EPSV); const float* gt = mod + (size_t)((l - 1) * 5 + nn[q]) * 3072 + 2048;
#pragma unroll
                for (int i = 0; i < 4; ++i) { const int col = (i * 64 + lane) * 4; const f32x4 g = *(const f32x4*)(gt + col), qq = *(const f32x4*)(gp + col); x[q][i] = x[q][i] + g * (y[q][i] * r * qq); } }
        }
#pragma unroll
        for (int q = 0; q < 2; ++q)
#pragma unroll
            for (int i = 0; i < 4; ++i) *(f32x4*)(p.out + (size_t)rows[q] * DM + (i * 64 + lane) * 4) = x[q][i];
        if (l < 4) {
            float ss[2];
#pragma unroll
            for (int q = 0; q < 2; ++q) { ss[q] = 0.f;
#pragma unroll
                for (int i = 0; i < 4; ++i) ss[q] += x[q][i][0] * x[q][i][0] + x[q][i][1] * x[q][i][1] + x[q][i][2] * x[q][i][2] + x[q][i][3] * x[q][i][3]; }
            ss[0] = wave_sum(ss[0]); ss[1] = wave_sum(ss[1]);
            const float* gp = p.g_pre + l * 1024;
#pragma unroll
            for (int q = 0; q < 2; ++q) { const float r = rsqrtf(ss[q] * (1.f / 1024.f) + EPSV); const float* sh = mod + (size_t)(l * 5 + nn[q]) * 3072; const float* scl = sh + 1024;
#pragma unroll
                for (int i = 0; i < 4; ++i) { const int col = (i * 64 + lane) * 4; const f32x4 a = *(const f32x4*)(sh + col), sv = *(const f32x4*)(scl + col), g = *(const f32x4*)(gp + col);
                    const f32x4 hv = x[q][i] * r * g * (sv + 1.f) + a; u32x2 w; w.x = pg8::cvt_pk_bf16(hv[0], hv[1]); w.y = pg8::cvt_pk_bf16(hv[2], hv[3]);
                    *(u32x2*)(hbuf + (size_t)rows[q] * DM + col) = w; } }
        }
    }
}

__device__ __forceinline__ void conv_tile(const float* W, int K, int N, bf16_t* Wt, int kt, int nt, LAS unsigned char* lds) {
    int tid_l = threadIdx.x; asm volatile("" : "+v"(tid_l)); const int tid = tid_l; LAS float* tile = (LAS float*)lds;
    const int k0 = kt * 64, n0 = nt * 64;
#pragma unroll
    for (int it = 0; it < 2; ++it) { const int r = it * 32 + (tid >> 4), c4 = (tid & 15) * 4; const f32x4 v = __builtin_nontemporal_load((const f32x4*)(W + (size_t)(k0 + r) * N + n0 + c4));
        tile[r * 65 + c4] = v[0]; tile[r * 65 + c4 + 1] = v[1]; tile[r * 65 + c4 + 2] = v[2]; tile[r * 65 + c4 + 3] = v[3]; }
    __syncthreads();
    { const int nn = tid >> 3, k8 = (tid & 7) * 8; u32x4 w;
      w.x = pg8::cvt_pk_bf16(tile[(k8 + 0) * 65 + nn], tile[(k8 + 1) * 65 + nn]); w.y = pg8::cvt_pk_bf16(tile[(k8 + 2) * 65 + nn], tile[(k8 + 3) * 65 + nn]);
      w.z = pg8::cvt_pk_bf16(tile[(k8 + 4) * 65 + nn], tile[(k8 + 5) * 65 + nn]); w.w = pg8::cvt_pk_bf16(tile[(k8 + 6) * 65 + nn], tile[(k8 + 7) * 65 + nn]);
      *(u32x4*)(Wt + (size_t)(n0 + nn) * K + k0 + k8) = w; }
    __syncthreads();
}
__device__ __forceinline__ void fold_unit(const Params& p, int j, int fu, LAS unsigned char* lds, bf16_t* Wt) {
    int tid_l = threadIdx.x; asm volatile("" : "+v"(tid_l)); const int tid = tid_l; const int g = fu >> 5, et = (fu >> 3) & 3, kt = fu & 7; const int e0 = et * 64, k0 = kt * 128;
    LAS float* As = (LAS float*)lds;
    LAS float* Bs = As + 32 * 64;
    const float* wp = p.w_pool + (size_t)(j * 4 + g) * 65536; const float* wi = p.w_in_ab + (size_t)j * 1024 * 7168 + 5120 + g * 256;
    const int e4 = (tid & 15) * 4, k4 = (tid >> 4) * 4;
    float acc[4][4];
#pragma unroll
    for (int i = 0; i < 4; ++i)
#pragma unroll
        for (int q = 0; q < 4; ++q) acc[i][q] = 0.f;
    for (int c0 = 0; c0 < 256; c0 += 32) {
        { const int r = tid >> 4, c4 = (tid & 15) * 4; const f32x4 v = __builtin_nontemporal_load((const f32x4*)(wp + (size_t)(c0 + r) * 256 + e0 + c4)); *(LAS f32x4*)(As + r * 64 + c4) = v; }
        { const int kk = tid >> 2, cc = (tid & 3) * 8; const float* src = wi + (size_t)(k0 + kk) * 7168 + c0 + cc; const f32x4 v0 = *(const f32x4*)src, v1 = *(const f32x4*)(src + 4);
          LAS float* d = Bs + kk * 33 + cc; d[0] = v0[0]; d[1] = v0[1]; d[2] = v0[2]; d[3] = v0[3]; d[4] = v1[0]; d[5] = v1[1]; d[6] = v1[2]; d[7] = v1[3]; }
        __syncthreads();
#pragma unroll 8
        for (int c = 0; c < 32; ++c) { const f32x4 a = *(LAS f32x4*)(As + c * 64 + e4);
#pragma unroll
            for (int i = 0; i < 4; ++i) { const float bv = Bs[(k4 + i) * 33 + c]; acc[i][0] += bv * a[0]; acc[i][1] += bv * a[1]; acc[i][2] += bv * a[2]; acc[i][3] += bv * a[3]; } }
        __syncthreads();
    }
#pragma unroll
    for (int q = 0; q < 4; ++q) { const int e = g * 256 + e0 + e4 + q; const float ps = p.pool_scale[j * 1024 + e];
        u32x2 w; w.x = pg8::cvt_pk_bf16(acc[0][q] * ps, acc[1][q] * ps); w.y = pg8::cvt_pk_bf16(acc[2][q] * ps, acc[3][q] * ps);
        *(u32x2*)(Wt + (size_t)(5120 + e) * 1024 + k0 + k4) = w; }
}
__device__ __forceinline__ void conv_tile2(const float* W0, int K0, int N0, bf16_t* Wt0, int kt0, int nt0, const float* W1, int K1, int N1, bf16_t* Wt1, int kt1, int nt1, LAS unsigned char* lds) {
    int tid_l = threadIdx.x; asm volatile("" : "+v"(tid_l)); const int tid = tid_l; LAS float* tileA = (LAS float*)lds; LAS float* tileB = tileA + 64 * 65;
    f32x4 va[2], vb[2];
#pragma unroll
    for (int it = 0; it < 2; ++it) { const int r = it * 32 + (tid >> 4), c4 = (tid & 15) * 4;
        va[it] = __builtin_nontemporal_load((const f32x4*)(W0 + (size_t)(kt0 * 64 + r) * N0 + nt0 * 64 + c4)); vb[it] = __builtin_nontemporal_load((const f32x4*)(W1 + (size_t)(kt1 * 64 + r) * N1 + nt1 * 64 + c4)); }
#pragma unroll
    for (int it = 0; it < 2; ++it) { const int r = it * 32 + (tid >> 4), c4 = (tid & 15) * 4;
        tileA[r * 65 + c4] = va[it][0]; tileA[r * 65 + c4 + 1] = va[it][1]; tileA[r * 65 + c4 + 2] = va[it][2]; tileA[r * 65 + c4 + 3] = va[it][3];
        tileB[r * 65 + c4] = vb[it][0]; tileB[r * 65 + c4 + 1] = vb[it][1]; tileB[r * 65 + c4 + 2] = vb[it][2]; tileB[r * 65 + c4 + 3] = vb[it][3]; }
    __syncthreads();
    { const int nn = tid >> 3, k8 = (tid & 7) * 8; u32x4 w;
      w.x = pg8::cvt_pk_bf16(tileA[(k8 + 0) * 65 + nn], tileA[(k8 + 1) * 65 + nn]); w.y = pg8::cvt_pk_bf16(tileA[(k8 + 2) * 65 + nn], tileA[(k8 + 3) * 65 + nn]);
      w.z = pg8::cvt_pk_bf16(tileA[(k8 + 4) * 65 + nn], tileA[(k8 + 5) * 65 + nn]); w.w = pg8::cvt_pk_bf16(tileA[(k8 + 6) * 65 + nn], tileA[(k8 + 7) * 65 + nn]);
      *(u32x4*)(Wt0 + (size_t)(nt0 * 64 + nn) * K0 + kt0 * 64 + k8) = w;
      w.x = pg8::cvt_pk_bf16(tileB[(k8 + 0) * 65 + nn], tileB[(k8 + 1) * 65 + nn]); w.y = pg8::cvt_pk_bf16(tileB[(k8 + 2) * 65 + nn], tileB[(k8 + 3) * 65 + nn]);
      w.z = pg8::cvt_pk_bf16(tileB[(k8 + 4) * 65 + nn], tileB[(k8 + 5) * 65 + nn]); w.w = pg8::cvt_pk_bf16(tileB[(k8 + 6) * 65 + nn], tileB[(k8 + 7) * 65 + nn]);
      *(u32x4*)(Wt1 + (size_t)(nt1 * 64 + nn) * K1 + kt1 * 64 + k8) = w; }
    __syncthreads();
}
__device__ __forceinline__ void phase_conv(const Params& p, int l, LAS unsigned char* lds, int mode, int wid, int nw) {
    const int j = l >> 1; const bool ab = (l & 1) == 0;
    const float* Win = ab ? p.w_in_ab + (size_t)j * 1024 * 7168 : p.w_in_c + (size_t)j * 1024 * 6144; const int Nin = ab ? 7168 : 6144;
    const float* Wout = ab ? p.w_out_ab + (size_t)j * 2048 * 1024 : p.w_out_c + (size_t)j * 2048 * 1024;
    bf16_t* WtIn = (bf16_t*)(p.ws + ws_win(l)); bf16_t* WtOut = (bf16_t*)(p.ws + ws_wout(l));
    const int n_in = (mode == 2) ? 0 : 1536, n_out = (mode == 1) ? 0 : 512, n_fold = (ab && mode != 2) ? 128 : 0, n_t = n_in + n_out;
    for (int u = wid; u < n_t; u += 2 * nw) {
        const float* W0; int K0, N0, kt0, nt0; bf16_t* T0;
        if (u < n_in) { nt0 = u >> 4; kt0 = u & 15; if (ab && nt0 >= 80) nt0 += 16; W0 = Win; K0 = 1024; N0 = Nin; T0 = WtIn; } else { const int v = u - n_in; kt0 = v & 31; nt0 = v >> 5; W0 = Wout; K0 = 2048; N0 = 1024; T0 = WtOut; }
        const int u1 = u + nw;
        if (u1 < n_t) { const float* W1; int K1, N1, kt1, nt1; bf16_t* T1;
            if (u1 < n_in) { nt1 = u1 >> 4; kt1 = u1 & 15; if (ab && nt1 >= 80) nt1 += 16; W1 = Win; K1 = 1024; N1 = Nin; T1 = WtIn; } else { const int v = u1 - n_in; kt1 = v & 31; nt1 = v >> 5; W1 = Wout; K1 = 2048; N1 = 1024; T1 = WtOut; }
            conv_tile2(W0, K0, N0, T0, kt0, nt0, W1, K1, N1, T1, kt1, nt1, lds); }
        else conv_tile(W0, K0, N0, T0, kt0, nt0, lds);
    }
    for (int u = wid; u < n_fold; u += nw) fold_unit(p, j, u, lds, WtIn);
}

constexpr int HG_QS = 0, HG_KS = 8704, HG_KT = 17408, HG_VT = 27648, HG_FAC = 37888, HG_BUF = 39424, HG_TOT = 2 * HG_BUF, HG_PT = HG_TOT + 2048;
__device__ __forceinline__ float clampe(float v) { return fminf(fmaxf(v, -80.f), 80.f); }
__device__ __forceinline__ void hgrn_unit(const Params& p, LAS unsigned char* lds, int j, bool sample, int b, int h, int dir) {
    int tid_l = threadIdx.x; asm volatile("" : "+v"(tid_l)); const int tid = tid_l, lane = tid & 63, w = tid >> 6, fr = lane & 15, hq = lane >> 4;
    const int T = sample ? 2048 : 256, nch = T >> 5;
    const size_t rowbase = sample ? (size_t)NPROMPT + (size_t)b * 2048 : (size_t)b * 256;
    bf16_t* proj = (bf16_t*)(p.ws + WS_PROJ);
    const int d = tid & 127, tq = tid >> 7;
    const float lbv = ((const float*)(p.ws + WS_LB))[(j * 2 + dir) * 1024 + h * 128 + d], oml = 1.f - lbv;
    f32x4 S[8];
    if (sample) { const float* s0 = p.state_hgrn + ((((size_t)b * 2 + j) * 2 + dir) * 8 + h) * 16384;
#pragma unroll
        for (int dt = 0; dt < 8; ++dt)
#pragma unroll
            for (int r = 0; r < 4; ++r) S[dt][r] = __builtin_nontemporal_load(s0 + (16 * dt + 4 * hq + r) * 128 + 16 * w + fr);
    } else {
#pragma unroll
        for (int dt = 0; dt < 8; ++dt) S[dt] = (f32x4){0.f, 0.f, 0.f, 0.f};
    }
    LAS float* TOT = (LAS float*)(lds + HG_TOT);
    bf16_t nq[8], nf[8], nv[8];
    const size_t cq = (size_t)h * 128 + d, cf = 1024 * (1 + dir) + (size_t)h * 128 + d, cv = 3072 + (size_t)h * 128 + d;
    const long rstride = dir ? -7168 : 7168;
#define HG_LOAD(c) do { const int pi0 = (c) * 32 + 8 * tq; const bf16_t* rp = proj + (rowbase + (dir ? (T - 1 - pi0) : pi0)) * 7168; \
        _Pragma("unroll") for (int i = 0; i < 8; ++i) { nq[i] = rp[cq]; nf[i] = rp[cf]; nv[i] = rp[cv]; rp += rstride; } } while (0)
    HG_LOAD(0);
    for (int c = 0; c < nch; ++c) {
        LAS unsigned char* buf = lds + (c & 1) * HG_BUF;
        LAS bf16_t* QS = (LAS bf16_t*)(buf + HG_QS); LAS bf16_t* KS = (LAS bf16_t*)(buf + HG_KS); LAS bf16_t* KT = (LAS bf16_t*)(buf + HG_KT); LAS bf16_t* VT = (LAS bf16_t*)(buf + HG_VT);
        LAS float* FAC = (LAS float*)(buf + HG_FAC);
        float Pc[8], kk[8], qs[8]; float pr = 1.f;
#pragma unroll
        for (int i = 0; i < 8; ++i) { const float k = bf2f(nf[i]); kk[i] = k; pr *= fmaxf(1.f - k, 1e-3f); Pc[i] = pr;     qs[i] = bf2f(nq[i]); }
        const float cs = __logf(pr);
        TOT[tq * 128 + d] = cs;
        __syncthreads();
        const float t0 = TOT[d], t1 = TOT[128 + d], t2 = TOT[256 + d], t3 = TOT[384 + d];
        const float off = (tq > 0 ? t0 : 0.f) + (tq > 1 ? t1 : 0.f) + (tq > 2 ? t2 : 0.f);
        const float R = t0 + t1, Bl = R + t2 + t3;
        bf16_t kbs[8];
        const float ebase = __expf(clampe(off - R));
#pragma unroll
        for (int i = 0; i < 8; ++i) { const int tl = 8 * tq + i;
            const float eq = fminf(fmaxf(ebase * Pc[i], 1e-30f), 1e30f), ek = __builtin_amdgcn_rcpf(eq);
            const unsigned qk = pg8::cvt_pk_bf16(qs[i] * eq, kk[i] * ek); const bf16_t qb = (bf16_t)(qk & 0xffffu), kb = (bf16_t)(qk >> 16);
            QS[tl * 136 + d] = qb; KS[tl * 136 + d] = kb; kbs[i] = kb; }
        { u32x4 kw, vw; kw.x = (unsigned)kbs[0] | ((unsigned)kbs[1] << 16); kw.y = (unsigned)kbs[2] | ((unsigned)kbs[3] << 16); kw.z = (unsigned)kbs[4] | ((unsigned)kbs[5] << 16); kw.w = (unsigned)kbs[6] | ((unsigned)kbs[7] << 16);
          vw.x = (unsigned)nv[0] | ((unsigned)nv[1] << 16); vw.y = (unsigned)nv[2] | ((unsigned)nv[3] << 16); vw.z = (unsigned)nv[4] | ((unsigned)nv[5] << 16); vw.w = (unsigned)nv[6] | ((unsigned)nv[7] << 16);
          *(LAS u32x4*)(KT + d * 40 + 8 * tq) = kw; *(LAS u32x4*)(VT + d * 40 + 8 * tq) = vw; }
        if (tq == 0) { FAC[d] = __expf(R); FAC[128 + d] = __expf(Bl); FAC[256 + d] = __expf(Bl - R); }
        if (c + 1 < nch) HG_LOAD(c + 1);
        __syncthreads();
        LAS bf16_t* PT = (LAS bf16_t*)(lds + HG_PT);
        const int wu = __builtin_amdgcn_readfirstlane(w);
        if (wu < 3) { const int sb = (wu == 2) ? 1 : 0, tb = (wu >= 1) ? 1 : 0;
            f32x4 sc = {0.f, 0.f, 0.f, 0.f};
#pragma unroll
            for (int ks = 0; ks < 4; ++ks) {
                const bf16x8 a = *(LAS bf16x8*)(KS + (16 * sb + fr) * 136 + ks * 32 + hq * 8), bq = *(LAS bf16x8*)(QS + (16 * tb + fr) * 136 + ks * 32 + hq * 8);
                sc = __builtin_amdgcn_mfma_f32_16x16x32_bf16(a, bq, sc, 0, 0, 0); }
            if (wu != 1) {
#pragma unroll
                for (int r = 0; r < 4; ++r) sc[r] = (fr >= 4 * hq + r) ? sc[r] : 0.f; }
            else {
#pragma unroll
                for (int r = 0; r < 4; ++r) sc[r] = sc[r] + 0.f; }
            u32x2 pk; pk.x = pg8::cvt_pk_bf16(sc[0], sc[1]); pk.y = pg8::cvt_pk_bf16(sc[2], sc[3]);
            *(LAS u32x2*)(PT + (tb * 16 + fr) * 40 + 16 * sb + 4 * hq) = pk;
        } else if (wu == 3) { u32x2 z; z.x = 0u; z.y = 0u; *(LAS u32x2*)(PT + fr * 40 + 16 + 4 * hq) = z; }
        const LAS bf16_t* vrow = VT + (16 * w + fr) * 40;
        f32x4 o0 = {0.f, 0.f, 0.f, 0.f}, o1 = o0;
#pragma unroll
        for (int ks = 0; ks < 4; ++ks) {
            const f32x4 e0 = *(LAS f32x4*)(FAC + 32 * ks + 4 * hq), e1 = *(LAS f32x4*)(FAC + 32 * ks + 16 + 4 * hq);
            const f32x4 x0 = S[2 * ks] * e0, x1 = S[2 * ks + 1] * e1;
            u32x4 sb; sb.x = pg8::cvt_pk_bf16(x0[0], x0[1]); sb.y = pg8::cvt_pk_bf16(x0[2], x0[3]); sb.z = pg8::cvt_pk_bf16(x1[0], x1[1]); sb.w = pg8::cvt_pk_bf16(x1[2], x1[3]);
            const LAS bf16_t* q0 = QS + fr * 136 + 32 * ks + 4 * hq; const LAS bf16_t* q1 = q0 + 16 * 136;
            u32x4 qa0, qa1; { const u32x2 lo = *(const LAS u32x2*)q0, hi = *(const LAS u32x2*)(q0 + 16); qa0.x = lo.x; qa0.y = lo.y; qa0.z = hi.x; qa0.w = hi.y; }
            { const u32x2 lo = *(const LAS u32x2*)q1, hi = *(const LAS u32x2*)(q1 + 16); qa1.x = lo.x; qa1.y = lo.y; qa1.z = hi.x; qa1.w = hi.y; }
            o0 = __builtin_amdgcn_mfma_f32_16x16x32_bf16(__builtin_bit_cast(bf16x8, qa0), __builtin_bit_cast(bf16x8, sb), o0, 0, 0, 0);
            o1 = __builtin_amdgcn_mfma_f32_16x16x32_bf16(__builtin_bit_cast(bf16x8, qa1), __builtin_bit_cast(bf16x8, sb), o1, 0, 0, 0);
        }
        { const bf16x8 vb8 = *(const LAS bf16x8*)(vrow + 8 * hq);
#pragma unroll
          for (int dt = 0; dt < 8; ++dt) {
              const bf16x8 ka = *(const LAS bf16x8*)(KT + (16 * dt + fr) * 40 + 8 * hq);
              f32x4 t = {0.f, 0.f, 0.f, 0.f};
              t = __builtin_amdgcn_mfma_f32_16x16x32_bf16(ka, vb8, t, 0, 0, 0);
              const f32x4 el = *(LAS f32x4*)(FAC + 128 + 16 * dt + 4 * hq), er = *(LAS f32x4*)(FAC + 256 + 16 * dt + 4 * hq);
              S[dt] = S[dt] * el + er * t;
          } }
        __syncthreads();
        { u32x4 pa0, pa1, vb;
          { const LAS bf16_t* p0 = PT + fr * 40 + 4 * hq; const u32x2 lo = *(const LAS u32x2*)p0, hi = *(const LAS u32x2*)(p0 + 16); pa0.x = lo.x; pa0.y = lo.y; pa0.z = hi.x; pa0.w = hi.y; }
          { const LAS bf16_t* p1 = PT + (16 + fr) * 40 + 4 * hq; const u32x2 lo = *(const LAS u32x2*)p1, hi = *(const LAS u32x2*)(p1 + 16); pa1.x = lo.x; pa1.y = lo.y; pa1.z = hi.x; pa1.w = hi.y; }
          { const u32x2 lo = *(const LAS u32x2*)(vrow + 4 * hq), hi = *(const LAS u32x2*)(vrow + 16 + 4 * hq); vb.x = lo.x; vb.y = lo.y; vb.z = hi.x; vb.w = hi.y; }
          o0 = __builtin_amdgcn_mfma_f32_16x16x32_bf16(__builtin_bit_cast(bf16x8, pa0), __builtin_bit_cast(bf16x8, vb), o0, 0, 0, 0);
          o1 = __builtin_amdgcn_mfma_f32_16x16x32_bf16(__builtin_bit_cast(bf16x8, pa1), __builtin_bit_cast(bf16x8, vb), o1, 0, 0, 0); }
        { const int pi0 = c * 32 + 4 * hq; bf16_t* op = proj + (rowbase + (dir ? (T - 1 - pi0) : pi0)) * 7168 + 1024 * (1 + dir) + h * 128 + 16 * w + fr;
#pragma unroll
          for (int r = 0; r < 4; ++r) { op[0] = f2bf(o0[r]); op[16 * rstride] = f2bf(o1[r]); op += rstride; } }
    }
#undef HG_LOAD
    if (!sample) { float* so = p.out + (size_t)NTOK * DM + ((((size_t)b * 2 + j) * 2 + dir) * 8 + h) * 16384;
#pragma unroll
        for (int dt = 0; dt < 8; ++dt)
#pragma unroll
            for (int r = 0; r < 4; ++r) so[(16 * dt + 4 * hq + r) * 128 + 16 * w + fr] = S[dt][r];
    }
    __syncthreads();
}

template <int W> __device__ __forceinline__ void pool_prompt_unit(const Params& p, int b, int slab) {
    int tid_l = threadIdx.x; asm volatile("" : "+v"(tid_l)); const int tid = tid_l, cp = tid & 31, seg = tid >> 5; const int ch = slab * 64 + 2 * cp, t0 = seg * 16;
    const bf16_t* proj = (const bf16_t*)(p.ws + WS_PROJ); bf16_t* ycat = (bf16_t*)(p.ws + WS_YCAT);
    float xa[16 + W], xb[16 + W];
#pragma unroll
    for (int i = 0; i < 16 + W; ++i) { const int t = t0 - W / 2 + i; float a = 0.f, bq = 0.f;
        if (t >= 0 && t < 256) { const unsigned v = *(const unsigned*)(proj + ((size_t)b * 256 + t) * 7168 + 5120 + ch); a = __uint_as_float(v << 16); bq = __uint_as_float(v & 0xffff0000u); }
        xa[i] = a; xb[i] = bq; }
    unsigned gvs[16];
#pragma unroll
    for (int k = 0; k < 16; ++k) gvs[k] = *(const unsigned*)(proj + ((size_t)b * 256 + t0 + k) * 7168 + 6144 + ch);
#pragma unroll
    for (int k = 0; k < 16; ++k) { const int t = t0 + k; float sa = 0.f, sb = 0.f;
#pragma unroll
        for (int i = 0; i < W; ++i) { sa += xa[k + i]; sb += xb[k + i]; }
        const int lo = max(t - W / 2, 0), hi = min(t - W / 2 + W, 256); const float inv = __builtin_amdgcn_rcpf((float)(hi - lo));
        const size_t row = (size_t)b * 256 + t; const unsigned gv = gvs[k];
        const float ya = (sa * inv - xa[k + W / 2]) * silu_f(__uint_as_float(gv << 16)), yb = (sb * inv - xb[k + W / 2]) * silu_f(__uint_as_float(gv & 0xffff0000u));
        *(unsigned*)(ycat + row * 2048 + 1024 + ch) = pg8::cvt_pk_bf16(ya, yb); }
}
template <int W> __device__ __forceinline__ void pool_sample_unit(const Params& p, LAS unsigned char* lds, int b, int g, int slab) {
    int tid_l = threadIdx.x; asm volatile("" : "+v"(tid_l)); const int tid = tid_l; const int chb = g * 256 + slab * 16;
    const bf16_t* proj = (const bf16_t*)(p.ws + WS_PROJ); bf16_t* ycat = (bf16_t*)(p.ws + WS_YCAT);
    LAS float* buf = (LAS float*)lds;
    const size_t rowb = (size_t)NPROMPT + (size_t)b * 2048;
    { const int cp = tid & 7, col = tid >> 3; float pa[33], pb[33]; pa[0] = 0.f; pb[0] = 0.f;
#pragma unroll
      for (int r = 0; r < 32; ++r) { const unsigned v = *(const unsigned*)(proj + (rowb + r * 64 + col) * 7168 + 5120 + chb + 2 * cp);
          pa[r + 1] = pa[r] + __uint_as_float(v << 16); pb[r + 1] = pb[r] + __uint_as_float(v & 0xffff0000u); }
#pragma unroll
      for (int r = 0; r < 32; ++r) { const int lo = (r - W / 2) > 0 ? (r - W / 2) : 0, hi = (r - W / 2 + W) < 32 ? (r - W / 2 + W) : 32; const float inv = 1.f / (float)(hi - lo);
          LAS float* dst = buf + r * 1040 + col * 16 + 2 * cp; dst[0] = (pa[hi] - pa[lo]) * inv; dst[1] = (pb[hi] - pb[lo]) * inv; } }
    __syncthreads();
    { const int chl = tid & 15, r = tid >> 4; float pc[65]; pc[0] = 0.f;
#pragma unroll
      for (int col = 0; col < 64; ++col) pc[col + 1] = pc[col] + buf[r * 1040 + col * 16 + chl];
#pragma unroll
      for (int cb = 0; cb < 2; ++cb) { bf16_t zz[32], gg[32];
#pragma unroll
          for (int c2 = 0; c2 < 32; ++c2) { const size_t row = rowb + r * 64 + cb * 32 + c2; zz[c2] = proj[row * 7168 + 5120 + chb + chl]; gg[c2] = proj[row * 7168 + 6144 + chb + chl]; }
#pragma unroll
          for (int c2 = 0; c2 < 32; ++c2) { const int col = cb * 32 + c2; const int lo = (col - W / 2) > 0 ? (col - W / 2) : 0, hi = (col - W / 2 + W) < 64 ? (col - W / 2 + W) : 64; const float inv = 1.f / (float)(hi - lo);
              const size_t row = rowb + r * 64 + col;
              ycat[row * 2048 + 1024 + chb + chl] = f2bf(((pc[hi] - pc[lo]) * inv - bf2f(zz[c2])) * silu_f(bf2f(gg[c2]))); } } }
    __syncthreads();
}

__device__ __forceinline__ void pool_unit(const Params& p, LAS unsigned char* lds, int u) {
    if (u < 64) { const int b = u >> 4, g = (u >> 2) & 3, sq = u & 3;
        for (int s4 = 0; s4 < 4; ++s4) { const int slab = sq * 4 + s4;
            if (g == 0) pool_sample_unit<2>(p, lds, b, g, slab); else if (g == 1) pool_sample_unit<4>(p, lds, b, g, slab); else if (g == 2) pool_sample_unit<8>(p, lds, b, g, slab); else pool_sample_unit<16>(p, lds, b, g, slab); } }
    else { const int v = u - 64, b = v >> 4, slab = v & 15, g = slab >> 2;
        if (g == 0) pool_prompt_unit<2>(p, b, slab); else if (g == 1) pool_prompt_unit<4>(p, b, slab); else if (g == 2) pool_prompt_unit<8>(p, b, slab); else pool_prompt_unit<16>(p, b, slab); }
}
__device__ __forceinline__ void phase_mix_ab(const Params& p, int j, int l_next, LAS unsigned char* lds) {
    const int bid = blockIdx.x, G = gridDim.x;
    if (G >= 128) {
        if (bid < 64) { hgrn_unit(p, lds, j, true, bid >> 4, (bid >> 1) & 7, bid & 1); return; }
        const int idx = bid - 64, nS = G - 64;
        for (int v = idx; v < 256; v += nS) hgrn_unit(p, lds, j, false, v >> 4, (v >> 1) & 7, v & 1);
        for (int u = nS - 1 - idx; u < 320; u += nS) pool_unit(p, lds, u);
        if (l_next < 4) phase_conv(p, l_next, lds, 0, idx, nS);
        if (l_next + 1 < 4) phase_conv(p, l_next + 1, lds, 1, idx, nS);
    } else {
        for (int u = bid; u < 320; u += G) { if (u < 64) hgrn_unit(p, lds, j, true, u >> 4, (u >> 1) & 7, u & 1); else { const int v = u - 64; hgrn_unit(p, lds, j, false, v >> 4, (v >> 1) & 7, v & 1); } }
        for (int u = bid; u < 320; u += G) pool_unit(p, lds, u);
        if (l_next < 4) phase_conv(p, l_next, lds, 0, bid, G);
        if (l_next + 1 < 4) phase_conv(p, l_next + 1, lds, 1, bid, G);
    }
}
__device__ __forceinline__ void phase_combine(const Params& p, int j) {
    int tid_l = threadIdx.x; asm volatile("" : "+v"(tid_l)); const int tid = tid_l, lane = tid & 63, wv = tid >> 6; const int hd = lane >> 3, e0 = (lane & 7) * 16;
    const bf16_t* proj = (const bf16_t*)(p.ws + WS_PROJ); bf16_t* ycat = (bf16_t*)(p.ws + WS_YCAT);
    float gn[16];
#pragma unroll
    for (int i = 0; i < 16; ++i) gn[i] = p.g_onorm[j * 128 + e0 + i];
    for (int tok = blockIdx.x * 8 + wv; tok < NTOK; tok += gridDim.x * 8) {
        const bf16_t* rp = proj + (size_t)tok * 7168 + hd * 128 + e0;
        const u32x4 f0 = *(const u32x4*)(rp + 1024), f1 = *(const u32x4*)(rp + 1024 + 8), b0 = *(const u32x4*)(rp + 2048), b1 = *(const u32x4*)(rp + 2048 + 8), g0 = *(const u32x4*)(rp + 4096), g1 = *(const u32x4*)(rp + 4096 + 8);
        float s[16], gt[16]; float ss = 0.f;
#pragma unroll
        for (int i = 0; i < 4; ++i) { s[2 * i] = __uint_as_float(f0[i] << 16) + __uint_as_float(b0[i] << 16); s[2 * i + 1] = __uint_as_float(f0[i] & 0xffff0000u) + __uint_as_float(b0[i] & 0xffff0000u);
            s[8 + 2 * i] = __uint_as_float(f1[i] << 16) + __uint_as_float(b1[i] << 16); s[8 + 2 * i + 1] = __uint_as_float(f1[i] & 0xffff0000u) + __uint_as_float(b1[i] & 0xffff0000u);
            gt[2 * i] = __uint_as_float(g0[i] << 16); gt[2 * i + 1] = __uint_as_float(g0[i] & 0xffff0000u); gt[8 + 2 * i] = __uint_as_float(g1[i] << 16); gt[8 + 2 * i + 1] = __uint_as_float(g1[i] & 0xffff0000u); }
#pragma unroll
        for (int i = 0; i < 16; ++i) ss += s[i] * s[i];
        ss += __shfl_xor(ss, 1); ss += __shfl_xor(ss, 2); ss += __shfl_xor(ss, 4);
        const float r = rsqrtf(ss * (1.f / 128.f) + EPSV);
        u32x4 w0, w1;
#pragma unroll
        for (int i = 0; i < 4; ++i) { w0[i] = pg8::cvt_pk_bf16(s[2 * i] * r * gn[2 * i] * silu_f(gt[2 * i]), s[2 * i + 1] * r * gn[2 * i + 1] * silu_f(gt[2 * i + 1]));
            w1[i] = pg8::cvt_pk_bf16(s[8 + 2 * i] * r * gn[8 + 2 * i] * silu_f(gt[8 + 2 * i]), s[8 + 2 * i + 1] * r * gn[8 + 2 * i + 1] * silu_f(gt[8 + 2 * i + 1])); }
        bf16_t* yp = ycat + (size_t)tok * 2048 + hd * 128 + e0; *(u32x4*)yp = w0; *(u32x4*)(yp + 8) = w1;
    }
}

constexpr int CM_VNT = 0, CM_WS = 69632, CM_MU = 104448;
__device__ __forceinline__ void phase_mix_c(const Params& p, int j, LAS unsigned char* lds) {
    int tid_l = threadIdx.x; asm volatile("" : "+v"(tid_l)); const int tid = tid_l, lane = tid & 63, w = tid >> 6, fr = lane & 15, hq = lane >> 4;
    const bf16_t* proj = (const bf16_t*)(p.ws + WS_PROJ); bf16_t* ycat = (bf16_t*)(p.ws + WS_YCAT); const float* stats = (const float*)(p.ws + WS_STATS);
    LAS bf16_t* VNT = (LAS bf16_t*)(lds + CM_VNT); LAS bf16_t* WSL = (LAS bf16_t*)(lds + CM_WS); LAS f32x2v* MU = (LAS f32x2v*)(lds + CM_MU);
    for (int unit = blockIdx.x; unit < 768; unit += gridDim.x) {
        const int g = unit & 7, n = unit >> 3; const size_t row0 = (size_t)n * 128;
        u32x4 va[4], vb[4];
        { const int sp_ = tid >> 3, cg_ = (tid & 7) * 32; const bf16_t* s0_ = proj + (row0 + 2 * sp_) * 6144 + 2048 + g * 256 + cg_;
#pragma unroll
          for (int i = 0; i < 4; ++i) { va[i] = *(const u32x4*)(s0_ + 8 * i); vb[i] = *(const u32x4*)(s0_ + 6144 + 8 * i); } }
        if (tid < 128) { float s = 0.f, q = 0.f;
#pragma unroll
            for (int i = 0; i < 8; ++i) { const float* sp = stats + ((size_t)i * NTOK + row0 + tid) * 8; const f32x4 v = *(const f32x4*)sp, v2 = *(const f32x4*)(sp + 4); s += (v[0] + v[2]) + (v2[0] + v2[2]); q += (v[1] + v[3]) + (v2[1] + v2[3]); }
            const float mean = s * (1.f / 2048.f); const float var = fmaxf(q * (1.f / 2048.f) - mean * mean, 0.f); MU[tid] = (f32x2v){mean, rsqrtf(var + EPSV)}; }
        if (unit == (int)blockIdx.x || (gridDim.x & 7) != 0)
        { const int t = tid >> 2, s0 = (tid & 3) * 32; const float* src = p.w_sp + ((size_t)(j * 8 + g) * 128 + t) * 128 + s0;
#pragma unroll
          for (int i = 0; i < 4; ++i) { const f32x4 a = *(const f32x4*)(src + 8 * i), bq = *(const f32x4*)(src + 8 * i + 4);
              u32x4 wv; wv.x = pg8::cvt_pk_bf16(a[0], a[1]); wv.y = pg8::cvt_pk_bf16(a[2], a[3]); wv.z = pg8::cvt_pk_bf16(bq[0], bq[1]); wv.w = pg8::cvt_pk_bf16(bq[2], bq[3]);
              *(LAS u32x4*)(WSL + t * 136 + s0 + 8 * i) = wv; } }
        __syncthreads();
        { const int sp = tid >> 3, cg = (tid & 7) * 32; const f32x2v m0 = MU[2 * sp], m1 = MU[2 * sp + 1];
          const bf16_t* s0 = proj + (row0 + 2 * sp) * 6144 + 2048 + g * 256 + cg; const bf16_t* s1 = s0 + 6144;
          const float* lg = p.ln_g + j * 2048 + g * 256 + cg; const float* lb = p.ln_b + j * 2048 + g * 256 + cg;
#pragma unroll
          for (int i = 0; i < 4; ++i) { const f32x4 g0 = *(const f32x4*)(lg + 8 * i), g1 = *(const f32x4*)(lg + 8 * i + 4), b0 = *(const f32x4*)(lb + 8 * i), b1 = *(const f32x4*)(lb + 8 * i + 4);
#pragma unroll
              for (int q = 0; q < 4; ++q) { const int c = cg + 8 * i + 2 * q; const float ga = (q < 2) ? g0[2 * q] : g1[2 * q - 4], gb = (q < 2) ? g0[2 * q + 1] : g1[2 * q - 3], ba = (q < 2) ? b0[2 * q] : b1[2 * q - 4], bb = (q < 2) ? b0[2 * q + 1] : b1[2 * q - 3];
                  const float x00 = __uint_as_float(va[i][q] << 16), x01 = __uint_as_float(va[i][q] & 0xffff0000u), x10 = __uint_as_float(vb[i][q] << 16), x11 = __uint_as_float(vb[i][q] & 0xffff0000u);
                  *(LAS unsigned*)(VNT + c * 136 + 2 * sp) = pg8::cvt_pk_bf16((x00 - m0.x) * m0.y * ga + ba, (x10 - m1.x) * m1.y * ga + ba);
                  *(LAS unsigned*)(VNT + (c + 1) * 136 + 2 * sp) = pg8::cvt_pk_bf16((x01 - m0.x) * m0.y * gb + bb, (x11 - m1.x) * m1.y * gb + bb); } } }
        __syncthreads();
        bf16x8 af[2][4];
#pragma unroll
        for (int ct = 0; ct < 2; ++ct)
#pragma unroll
            for (int ks = 0; ks < 4; ++ks) af[ct][ks] = *(const LAS bf16x8*)(VNT + (32 * w + 8 * (fr >> 2) + 4 * ct + (fr & 3)) * 136 + 32 * ks + 8 * hq);
        const float* bsp = p.b_sp + (size_t)(j * 8 + g) * 128;
        f32x4 acc[8][2];
#pragma unroll
        for (int tt = 0; tt < 8; ++tt) {
            f32x4 a0 = {0.f, 0.f, 0.f, 0.f}, a1 = a0;
#pragma unroll
            for (int ks = 0; ks < 4; ++ks) { const bf16x8 bf = *(const LAS bf16x8*)(WSL + (16 * tt + fr) * 136 + 32 * ks + 8 * hq);
                a0 = __builtin_amdgcn_mfma_f32_16x16x32_bf16(af[0][ks], bf, a0, 0, 0, 0); a1 = __builtin_amdgcn_mfma_f32_16x16x32_bf16(af[1][ks], bf, a1, 0, 0, 0); }
            acc[tt][0] = a0; acc[tt][1] = a1;
        }
#pragma unroll
        for (int tb = 0; tb < 2; ++tb) {
            u32x4 uu[4], gg[4]; float bs[4]; const int c = g * 256 + 32 * w + 8 * hq;
#pragma unroll
            for (int t4 = 0; t4 < 4; ++t4) { const int tt = tb * 4 + t4; const size_t row = row0 + 16 * tt + fr; bs[t4] = bsp[16 * tt + fr];
                uu[t4] = *(const u32x4*)(proj + row * 6144 + c); gg[t4] = *(const u32x4*)(proj + row * 6144 + 4096 + c); }
#pragma unroll
            for (int t4 = 0; t4 < 4; ++t4) { const int tt = tb * 4 + t4; const size_t row = row0 + 16 * tt + fr; const float bq = bs[t4]; u32x4 o;
#pragma unroll
                for (int ct = 0; ct < 2; ++ct) { const f32x4 a = acc[tt][ct]; const unsigned ux = uu[t4][2 * ct], uy = uu[t4][2 * ct + 1], gx = gg[t4][2 * ct], gy = gg[t4][2 * ct + 1];
                    const float y0 = __uint_as_float(ux << 16) * (a[0] + bq) * silu_f(__uint_as_float(gx << 16)), y1 = __uint_as_float(ux & 0xffff0000u) * (a[1] + bq) * silu_f(__uint_as_float(gx & 0xffff0000u));
                    const float y2 = __uint_as_float(uy << 16) * (a[2] + bq) * silu_f(__uint_as_float(gy << 16)), y3 = __uint_as_float(uy & 0xffff0000u) * (a[3] + bq) * silu_f(__uint_as_float(gy & 0xffff0000u));
                    o[2 * ct] = pg8::cvt_pk_bf16(y0, y1); o[2 * ct + 1] = pg8::cvt_pk_bf16(y2, y3); }
                *(u32x4*)(ycat + row * 2048 + c) = o; }
        }
        __syncthreads();
    }
}

#ifdef DIAG_L
__device__ __forceinline__ void diag_dump_bf16(const Params& p, const bf16_t* buf, int K) {
    for (size_t i = (size_t)blockIdx.x * 512 + threadIdx.x; i < (size_t)NTOK * DM; i += (size_t)gridDim.x * 512) { float a = 0.f; for (int k = 0; k < K; ++k) a += bf2f(buf[i + (size_t)k * NTOK * DM]); p.out[i] = (float)((__float_as_uint(a) * 2654435761u) >> 16) * (1.f / 65536.f); }
}
__device__ __forceinline__ void diag_dump_f32(const Params& p, const float* buf) {
    for (size_t i = (size_t)blockIdx.x * 512 + threadIdx.x; i < (size_t)NTOK * DM; i += (size_t)gridDim.x * 512) p.out[i] = (float)((__float_as_uint(buf[i]) * 2654435761u) >> 16) * (1.f / 65536.f);
}
#endif
__global__ void __launch_bounds__(512, 2) mega_fwd(Params p) {
    extern __shared__ __attribute__((aligned(16))) unsigned char shm[];
    LAS unsigned char* lds = (LAS unsigned char*)shm;
    volatile LAS unsigned* bst = (volatile LAS unsigned*)(lds + LDS_BYTES - 16);
    if (threadIdx.x < 4) bst[threadIdx.x] = 0u;
    __syncthreads();
    XcdBarrier bar = xcd_barrier_post((unsigned*)(p.ws + WS_BAR), bst);
    phase_mod(p, lds);
    cg::this_grid().sync();
    xcd_barrier(bar);
    bf16_t* hbuf = (bf16_t*)(p.ws + WS_YCAT); bf16_t* ycat = hbuf; bf16_t* projb = (bf16_t*)(p.ws + WS_PROJ);
#ifdef DIAG_MOD
    { const float* md = (const float*)(p.ws + WS_MOD);
      for (size_t i = (size_t)blockIdx.x * 512 + threadIdx.x; i < (size_t)NTOK * DM; i += (size_t)gridDim.x * 512) p.out[i] = i < 61440 ? md[i] : 0.f;
      return; }
#endif
    for (int l = 0; l < 4; ++l) {
        const int j = l >> 1; const bool ab = (l & 1) == 0;
        phase_row(p, l);
#ifdef DIAG_STOP_LAYER
        if (l == DIAG_STOP_LAYER) {
#ifdef DIAG_BITS
            xcd_barrier(bar);
            for (size_t i = (size_t)blockIdx.x * 512 + threadIdx.x; i < (size_t)NTOK * DM; i += (size_t)gridDim.x * 512) { const unsigned u = __float_as_uint(p.out[i]); p.out[i] = (float)((u * 2654435761u) >> 16) * (1.f / 65536.f); }
#endif
#ifdef DIAG_MOD2
            xcd_barrier(bar);
            { const float* md = (const float*)(p.ws + WS_MOD);
              for (size_t i = (size_t)blockIdx.x * 512 + threadIdx.x; i < (size_t)NTOK * DM; i += (size_t)gridDim.x * 512) p.out[i] = i < 61440 ? md[i] : 0.f; }
#endif
            return; }
#endif
        if (l == 0) phase_conv(p, 0, lds, 0, (int)blockIdx.x, (int)gridDim.x);
        else if (l == 2) phase_conv(p, 2, lds, 2, (int)blockIdx.x, (int)gridDim.x);
        xcd_barrier(bar);
#ifdef DIAG_L
        if (l == DIAG_L && DIAG_S == 0) { unsigned* hb = (unsigned*)hbuf;
            for (size_t i = (size_t)blockIdx.x * 512 + threadIdx.x; i < (size_t)NTOK * DM / 2; i += (size_t)gridDim.x * 512) { const unsigned v = __hip_atomic_load(hb + i, __ATOMIC_RELAXED, __HIP_MEMORY_SCOPE_AGENT);
                p.out[2 * i] = __uint_as_float(v << 16); p.out[2 * i + 1] = __uint_as_float(v & 0xffff0000u); }
            return; }
#endif
        { pg8::StaticOrder S; pg8::Gemm g; g.A = hbuf; g.Bt = (const bf16_t*)(p.ws + ws_win(l)); g.M = NTOK; g.K = 1024;
          if (ab) { g.N = 7168; S.init(g.M, g.N, (int)gridDim.x, (int)blockIdx.x); pg8::EpiBf16S E; E.O = projb; E.ldc = 7168; E.stats = nullptr; E.st_lo = 0; E.st_hi = 0; E.sl_hi = 4; E.kg_hi = 12; E.lbp = (const float*)(p.ws + WS_LB) + j * 2048;
              pg8::gemm_phase<pg8::EpiBf16S, pg8::StaticOrder, false>(lds, g, S, E, nullptr); }
          else { g.N = 6144; S.init(g.M, g.N, (int)gridDim.x, (int)blockIdx.x); pg8::EpiBf16S E; E.O = projb; E.ldc = 6144; E.stats = (float*)(p.ws + WS_STATS); E.st_lo = 8; E.st_hi = 16; E.sl_hi = 0; E.kg_hi = 0; E.lbp = nullptr;
              pg8::gemm_phase<pg8::EpiBf16S, pg8::StaticOrder, false>(lds, g, S, E, nullptr); } }
        xcd_barrier(bar);
#ifdef DIAG_L
        if (l == DIAG_L && DIAG_S == 1) { diag_dump_bf16(p, projb, ab ? 7 : 6); return; }
#endif
        if (ab) { phase_mix_ab(p, j, l + 1, lds); xcd_barrier(bar); phase_combine(p, j); }
        else phase_mix_c(p, j, lds);
        xcd_barrier(bar);
#ifdef DIAG_L
        if (l == DIAG_L && DIAG_S == 2) { diag_dump_bf16(p, ycat, 2); return; }
        if (l == DIAG_L && DIAG_S == 4) {
            for (size_t i = (size_t)blockIdx.x * 512 + threadIdx.x; i < (size_t)NTOK * DM; i += (size_t)gridDim.x * 512) { const size_t rr = i >> 10; const float a = (rr >= DIAG_R0 && rr < DIAG_R1) ? bf2f(ycat[rr * 2048 + (i & 1023) + DIAG_HALF * 1024]) : 0.f;
                p.out[i] = (float)((__float_as_uint(a) * 2654435761u) >> 16) * (1.f / 65536.f); }
            return; }
#endif
        { pg8::StaticOrder S; pg8::Gemm g; g.A = ycat; g.Bt = (const bf16_t*)(p.ws + ws_wout(l)); g.M = NTOK; g.N = 1024; g.K = 2048; S.init(g.M, g.N, (int)gridDim.x, (int)blockIdx.x);
          pg8::EpiBf16S E; E.O = projb; E.ldc = 1024; E.stats = nullptr; E.st_lo = 0; E.st_hi = 0; E.sl_hi = 0; E.kg_hi = 0; E.lbp = nullptr;
          pg8::gemm_phase<pg8::EpiBf16S, pg8::StaticOrder, false>(lds, g, S, E, nullptr); }
        xcd_barrier(bar);
#ifdef DIAG_L
        if (l == DIAG_L && DIAG_S == 3) { diag_dump_f32(p, (const float*)(p.ws + WS_PROJ)); return; }
#endif
    }
    phase_row(p, 4);
}

extern "C" void kernel_launch(void* const* d_in, const int* in_sizes, int n_in, void* d_out, int out_size, void* d_ws, size_t ws_size, hipStream_t stream) {
    static int grid = 0;
    if (grid == 0) {
        if (n_in != 21 || ws_size < WS_END) { fprintf(stderr, "kernel_launch: unexpected n_in %d / ws_size %zu (need %zu)\n", n_in, ws_size, (size_t)WS_END); grid = -1; return; }
        int dev = 0, cus = 0, per_cu = 0;
        hipGetDevice(&dev); hipDeviceGetAttribute(&cus, hipDeviceAttributeMultiprocessorCount, dev);
        if (hipFuncSetAttribute((const void*)mega_fwd, hipFuncAttributeMaxDynamicSharedMemorySize, LDS_BYTES) != hipSuccess) { fprintf(stderr, "kernel_launch: hipFuncSetAttribute failed\n"); grid = -1; return; }
        hipOccupancyMaxActiveBlocksPerMultiprocessor(&per_cu, (const void*)mega_fwd, 512, LDS_BYTES);
        (void)hipGetLastError();
        if (per_cu < 1) { fprintf(stderr, "kernel_launch: occupancy query says %d blocks per CU\n", per_cu); }
        grid = cus;
    }
    if (grid < 0) return;
    hipMemsetAsync((char*)d_ws + WS_BAR, 0, 16384, stream);
    Params p{};
    p.x_prompt = (const float*)d_in[0]; p.x_sample = (const float*)d_in[1]; p.c = (const float*)d_in[2]; p.state_hgrn = (const float*)d_in[3]; p.c_ctx = (const float*)d_in[4];
    p.w_ada = (const float*)d_in[5]; p.b_ada = (const float*)d_in[6]; p.g_pre = (const float*)d_in[7]; p.g_post = (const float*)d_in[8]; p.w_in_ab = (const float*)d_in[9];
    p.w_out_ab = (const float*)d_in[10]; p.lb_logits = (const float*)d_in[11]; p.g_onorm = (const float*)d_in[12]; p.w_pool = (const float*)d_in[13]; p.pool_scale = (const float*)d_in[14];
    p.w_in_c = (const float*)d_in[15]; p.w_out_c = (const float*)d_in[16]; p.ln_g = (const float*)d_in[17]; p.ln_b = (const float*)d_in[18]; p.w_sp = (const float*)d_in[19]; p.b_sp = (const float*)d_in[20];
    p.out = (float*)d_out; p.ws = (unsigned char*)d_ws;
    void* args[] = {&p};
    hipError_t e = hipLaunchCooperativeKernel((const void*)mega_fwd, dim3(grid), dim3(512), args, LDS_BYTES, stream);
    if (e != hipSuccess) fprintf(stderr, "kernel_launch: cooperative launch failed: %s (grid %d)\n", hipGetErrorString(e), grid);
}
```

```cpp
#include <hip/hip_runtime.h>
#include <hip/hip_cooperative_groups.h>
#include <cstdio>
namespace cg = cooperative_groups;
namespace pg8 {
#define PG8_LAS __attribute__((address_space(3)))
typedef unsigned short bf16_t;
typedef short bf16x8 __attribute__((ext_vector_type(8)));
typedef float f32x4 __attribute__((ext_vector_type(4)));
typedef unsigned u32x4 __attribute__((ext_vector_type(4)));
constexpr int BM = 256, BK = 64, HALF = 128, HTB = HALF * BK * 2  , STAGE_BYTES = 8 * HTB, NXCD = 8, WGM = 8;

__host__ __device__ __forceinline__ int lds_byte(int r, int c) { const int st = (r >> 4) * 2 + (c >> 5), rr = r & 15, cc = c & 31, ob = rr * 64 + cc * 2; return st * 1024 + (ob ^ (((ob >> 9) & 1) << 5)); }
__host__ __device__ __forceinline__ void stage_rc(int b, int& R, int& C) { const int st = b / 1024, sb = b % 1024, swz = sb ^ (((sb >> 9) & 1) << 5); R = (st >> 1) * 16 + swz / 64; C = (st & 1) * 32 + (swz % 64) / 2; }
__host__ __device__ __forceinline__ int perm32(int rho) { const int n = rho >> 4, i = rho & 15; return 8 * (i >> 2) + 4 * n + (i & 3); }

struct Unit { int pm, pn; };
struct Gemm { const bf16_t* A; const bf16_t* Bt; int M, N, K; };

struct StaticOrder {
    int nM, nN, nwg, G, c;
    __host__ __device__ void init(int M, int N, int G_, int c_) { nM = M / BM; nN = N / BM; nwg = nM * nN; G = G_; c = c_; }
    __host__ __device__ bool next(int i, Unit& u) const {
        const long L = (long)i * G + c; if (L >= nwg) return false;
        int wgid = (int)L; { const int q = nwg / NXCD, r = nwg % NXCD, xcd = wgid % NXCD, off = wgid / NXCD; wgid = (xcd < r ? xcd * (q + 1) : r * (q + 1) + (xcd - r) * q) + off; }
        const int nig = WGM * nN, gid = wgid / nig, fm = gid * WGM, gsz = (nM - fm) < WGM ? (nM - fm) : WGM;
        u.pm = fm + ((wgid % nig) % gsz); u.pn = (wgid % nig) / gsz; return true;
    }
    __device__ __forceinline__ void a_ready(const Unit&) const {}
    __device__ __forceinline__ void done(const Unit&) const {}
};
__device__ __forceinline__ unsigned cvt_pk_bf16(float lo, float hi) { unsigned r; asm volatile("v_cvt_pk_bf16_f32 %0, %1, %2\n\ts_nop 1" : "=v"(r) : "v"(lo), "v"(hi)); return r; }
typedef float f32x2 __attribute__((ext_vector_type(2)));
struct EpiF32 {
    static constexpr bool PERM = false, AFTER_DRAIN = false;
    float* C; int ldc;
    __device__ __forceinline__ void operator()(const f32x4 (&acc)[2][2][4][2], const Unit& u, int wr, int wc, int fr, int fq) const {
        const int row0 = u.pm * BM + wr * 64 + fr, col0 = u.pn * BM + wc * 32 + 4 * fq;
#pragma unroll
        for (int ai = 0; ai < 2; ++ai)
#pragma unroll
            for (int m = 0; m < 4; ++m) { float* rowp = C + (size_t)(row0 + ai * HALF + m * 16) * ldc + col0;
#pragma unroll
                for (int bj = 0; bj < 2; ++bj)
#pragma unroll
                    for (int n = 0; n < 2; ++n) *(f32x4*)(rowp + bj * HALF + n * 16) = acc[ai][bj][m][n]; }
    }
};
struct EpiBf16S {
    static constexpr bool PERM = true, AFTER_DRAIN = false;
    bf16_t* O; int ldc; float* stats; int st_lo, st_hi; int sl_hi; const float* lbp; int kg_hi;
    __device__ __forceinline__ void operator()(const f32x4 (&acc)[2][2][4][2], const Unit& u, int wr, int wc, int fr, int fq) const {
        const int row0 = u.pm * BM + wr * 64 + fr; const int col0 = u.pn * BM + wc * 32 + 8 * fq;
        const bool dost = (stats != nullptr) && u.pn >= st_lo && u.pn < st_hi;
        const bool dosl = u.pn < sl_hi; const bool dokg = u.pn >= sl_hi && u.pn < kg_hi;
#pragma unroll
        for (int ai = 0; ai < 2; ++ai)
#pragma unroll
            for (int m = 0; m < 4; ++m) { const int row = row0 + ai * HALF + m * 16; bf16_t* rowp = O + (size_t)row * ldc + col0; float s = 0.f, q = 0.f;
#pragma unroll
                for (int bj = 0; bj < 2; ++bj) { f32x4 v0 = acc[ai][bj][m][0] + 0.f, v1 = acc[ai][bj][m][1] + 0.f;
                    if (dokg) { const float* lq = lbp + (col0 + bj * HALF - 256 * sl_hi); const f32x4 l0 = *(const f32x4*)lq, l1 = *(const f32x4*)(lq + 4);
#pragma unroll
                        for (int q4 = 0; q4 < 4; ++q4) { v0[q4] = (1.f - l0[q4]) * __builtin_amdgcn_rcpf(1.f + __expf(v0[q4])); v1[q4] = (1.f - l1[q4]) * __builtin_amdgcn_rcpf(1.f + __expf(v1[q4])); } }
                    if (dosl) {
#pragma unroll
                        for (int q4 = 0; q4 < 4; ++q4) { v0[q4] = v0[q4] * __builtin_amdgcn_rcpf(1.f + __expf(-v0[q4])); v1[q4] = v1[q4] * __builtin_amdgcn_rcpf(1.f + __expf(-v1[q4])); } }
                    u32x4 w; w.x = cvt_pk_bf16(v0[0], v0[1]); w.y = cvt_pk_bf16(v0[2], v0[3]); w.z = cvt_pk_bf16(v1[0], v1[1]); w.w = cvt_pk_bf16(v1[2], v1[3]);
                    *(u32x4*)(rowp + bj * HALF) = w;
                    s += (v0[0] + v0[1]) + (v0[2] + v0[3]) + (v1[0] + v1[1]) + (v1[2] + v1[3]);
                    q += (v0[0] * v0[0] + v0[1] * v0[1]) + (v0[2] * v0[2] + v0[3] * v0[3]) + (v1[0] * v1[0] + v1[1] * v1[1]) + (v1[2] * v1[2] + v1[3] * v1[3]); }
                if (dost) { s += __shfl_xor(s, 16); s += __shfl_xor(s, 32); q += __shfl_xor(q, 16); q += __shfl_xor(q, 32);
                    if (fq == 0) { float* sp = stats + (((size_t)(u.pn - st_lo) * 12288 + row) * 4 + wc) * 2; sp[0] = s; sp[1] = q; } } }
    }
};
template <class Epi, class Sched, bool STAMP = false>
__device__ __forceinline__ void gemm_phase(PG8_LAS unsigned char* lds, const Gemm g, const Sched& S, const Epi& E, unsigned long long* stamps) {
    int tid_l = threadIdx.x; asm volatile("" : "+v"(tid_l));
    const int tid = tid_l, wid = __builtin_amdgcn_readfirstlane(tid >> 6), lane = tid & 63, wr = wid >> 2, wc = wid & 3, fr = lane & 15, fq = lane >> 4;
    const int K = g.K, nt = K / BK;
    int ts_lo = 0, ts_hi = 0, nts = 0; const unsigned long long rt_entry = STAMP ? (unsigned long long)wall_clock64() : 0ull;
#define PG8_STAMP() do { if (STAMP && wid == 0 && nts < 64) { const unsigned long long _c = (unsigned long long)clock64(); \
        ts_lo = (lane == nts) ? (int)(unsigned)_c : ts_lo; ts_hi = (lane == nts) ? (int)(unsigned)(_c >> 32) : ts_hi; ++nts; } } while (0)
    PG8_STAMP();
    unsigned voffA[2], voffB[2];
#pragma unroll
    for (int i = 0; i < 2; ++i) { int R, C; stage_rc(tid * 16 + i * 8192, R, C); const int Rb = Epi::PERM ? ((R & ~31) + perm32(R & 31)) : R;
        voffA[i] = (unsigned)(R * K + C) * 2u; voffB[i] = (unsigned)(Rb * K + C) * 2u; }
    const size_t kstep = (size_t)(BK * 2);
    const size_t hstep = (size_t)HALF * K * 2;
    const size_t tstep = 2 * hstep;
    const unsigned ldsw = (unsigned)wid * 1024u;
    const int aoff = lds_byte(wr * 64 + fr, fq * 8), boff = lds_byte(wc * 32 + fr, fq * 8);
#define PG8_SA(b, h) (((b) * 2 + (h)) * HTB)
#define PG8_SB(b, h) ((4 + (b) * 2 + (h)) * HTB)
#define PG8_STAGE(bufoff, gbase, voff) do { _Pragma("unroll") for (int _i = 0; _i < 2; ++_i) \
        __builtin_amdgcn_global_load_lds((const unsigned*)((const char*)(gbase) + (voff)[_i]), (PG8_LAS unsigned*)(lds + (bufoff) + ldsw + _i * 8192), 16, 0, 0); } while (0)
#define PG8_LDA(dst, b, h) do { _Pragma("unroll") for (int m = 0; m < 4; ++m) _Pragma("unroll") for (int k = 0; k < 2; ++k) dst[m][k] = *(const PG8_LAS bf16x8*)(lds + PG8_SA(b, h) + aoff + m * 2048 + k * 1024); } while (0)
#define PG8_LDB(dst, b, h) do { _Pragma("unroll") for (int n = 0; n < 2; ++n) _Pragma("unroll") for (int k = 0; k < 2; ++k) dst[n][k] = *(const PG8_LAS bf16x8*)(lds + PG8_SB(b, h) + boff + n * 2048 + k * 1024); } while (0)
#define PG8_MMA(ai, bj, At, Bt) do { __builtin_amdgcn_s_setprio(1); _Pragma("unroll") for (int m = 0; m < 4; ++m) _Pragma("unroll") for (int n = 0; n < 2; ++n) _Pragma("unroll") for (int k = 0; k < 2; ++k) \
        acc[ai][bj][m][n] = __builtin_amdgcn_mfma_f32_16x16x32_bf16(Bt[n][k], At[m][k], acc[ai][bj][m][n], 0, 0, 0); __builtin_amdgcn_s_setprio(0); } while (0)
#define PG8_WAIT_V(n) asm volatile("s_waitcnt vmcnt(" #n ")" ::: "memory")
#define PG8_WAIT_L(n) asm volatile("s_waitcnt lgkmcnt(" #n ")" ::: "memory")
#define PG8_BAR __builtin_amdgcn_s_barrier()
#define PG8_SCHED __builtin_amdgcn_sched_barrier(0)
    Unit cur, nxt; int ui = 0;
    if (!S.next(0, cur)) return;
    f32x4 acc[2][2][4][2];
#pragma unroll
    for (int a = 0; a < 2; ++a)
#pragma unroll
        for (int b = 0; b < 2; ++b)
#pragma unroll
            for (int m = 0; m < 4; ++m)
#pragma unroll
                for (int n = 0; n < 2; ++n) acc[a][b][m][n] = (f32x4){0.f, 0.f, 0.f, 0.f};
    bf16x8 At[4][2], B0[2][2], B1[2][2];
    const char* cA = (const char*)g.A + (size_t)cur.pm * tstep; const char* cB = (const char*)g.Bt + (size_t)cur.pn * tstep;
    S.a_ready(cur);
    PG8_STAGE(PG8_SB(0, 0), cB, voffB); PG8_STAGE(PG8_SA(0, 0), cA, voffA); PG8_STAGE(PG8_SB(0, 1), cB + hstep, voffB); PG8_STAGE(PG8_SA(0, 1), cA + hstep, voffA);
    if (wr == 1) PG8_BAR;
    PG8_WAIT_V(4); PG8_BAR;
    PG8_STAGE(PG8_SB(1, 0), cB + kstep, voffB); PG8_STAGE(PG8_SA(1, 0), cA + kstep, voffA); PG8_STAGE(PG8_SB(1, 1), cB + hstep + kstep, voffB);
    PG8_WAIT_V(6); PG8_BAR;
    PG8_STAMP();
    for (;;) {
        const bool has_next = S.next(ui + 1, nxt);
        const char* nA = has_next ? (const char*)g.A + (size_t)nxt.pm * tstep : cA; const char* nB = has_next ? (const char*)g.Bt + (size_t)nxt.pn * tstep : cB;
        for (int t = 0; t < nt; t += 2) {
            const bool last = (t == nt - 2);
            const char* a1 = cA + (size_t)(t + 1) * kstep;
            const char* a2 = last ? nA : cA + (size_t)(t + 2) * kstep; const char* b2 = last ? nB : cB + (size_t)(t + 2) * kstep;
            const char* a3 = a2 + kstep; const char* b3 = b2 + kstep;
            if (last && has_next) S.a_ready(nxt);
            PG8_LDB(B0, 0, 0); PG8_SCHED; PG8_LDA(At, 0, 0); PG8_STAGE(PG8_SA(1, 1), a1 + hstep, voffA);
            PG8_WAIT_L(8); PG8_BAR; PG8_WAIT_L(0); PG8_MMA(0, 0, At, B0); PG8_BAR; PG8_SCHED;
            PG8_LDB(B1, 0, 1); PG8_STAGE(PG8_SB(0, 0), b2, voffB);
            PG8_BAR; PG8_WAIT_L(0); PG8_MMA(0, 1, At, B1); PG8_BAR;
            PG8_LDA(At, 0, 1); PG8_STAGE(PG8_SA(0, 0), a2, voffA);
            PG8_BAR; PG8_WAIT_L(0); PG8_MMA(1, 0, At, B0); PG8_BAR; PG8_SCHED;
            PG8_STAGE(PG8_SB(0, 1), b2 + hstep, voffB);
            PG8_WAIT_V(6); PG8_BAR; PG8_MMA(1, 1, At, B1); PG8_BAR;
            PG8_LDB(B0, 1, 0); PG8_SCHED; PG8_LDA(At, 1, 0); PG8_STAGE(PG8_SA(0, 1), a2 + hstep, voffA);
            PG8_WAIT_L(8); PG8_BAR; PG8_WAIT_L(0); PG8_MMA(0, 0, At, B0); PG8_BAR; PG8_SCHED;
            PG8_LDB(B1, 1, 1); PG8_STAGE(PG8_SB(1, 0), b3, voffB);
            PG8_BAR; PG8_WAIT_L(0); PG8_MMA(0, 1, At, B1); PG8_BAR;
            PG8_LDA(At, 1, 1); PG8_STAGE(PG8_SA(1, 0), a3, voffA);
            PG8_BAR; PG8_WAIT_L(0); PG8_MMA(1, 0, At, B0); PG8_BAR; PG8_SCHED;
            PG8_STAGE(PG8_SB(1, 1), b3 + hstep, voffB);
            PG8_WAIT_V(6); PG8_BAR; PG8_MMA(1, 1, At, B1); PG8_BAR;
        }
        PG8_STAMP();
        if constexpr (!Epi::AFTER_DRAIN) { E(acc, cur, wr, wc, fr, fq); S.done(cur); }
        PG8_STAMP();
        if (!has_next) break;
#pragma unroll
        for (int a = 0; a < 2; ++a)
#pragma unroll
            for (int b = 0; b < 2; ++b)
#pragma unroll
                for (int m = 0; m < 4; ++m)
#pragma unroll
                    for (int n = 0; n < 2; ++n) acc[a][b][m][n] = (f32x4){0.f, 0.f, 0.f, 0.f};
        cur = nxt; cA = nA; cB = nB; ++ui;
    }
    PG8_WAIT_V(0);
    if (wr == 0) PG8_BAR;
    PG8_BAR;
    if constexpr (Epi::AFTER_DRAIN) { E.fused(acc, cur, wr, wc, fr, fq, lds, wid, lane); S.done(cur); }
    PG8_STAMP();
    if (STAMP && wid == 0) { stamps[lane] = lane < nts ? (((unsigned long long)(unsigned)ts_hi << 32) | (unsigned)ts_lo) : 0ull;
        if (lane == 62) stamps[62] = rt_entry; if (lane == 63) stamps[63] = (unsigned long long)wall_clock64(); }
#undef PG8_STAMP
#undef PG8_SA
#undef PG8_SB
#undef PG8_STAGE
#undef PG8_LDA
#undef PG8_LDB
#undef PG8_MMA
#undef PG8_WAIT_V
#undef PG8_WAIT_L
#undef PG8_BAR
#undef PG8_SCHED
}
}

#define LAS __attribute__((address_space(3)))
using pg8::bf16_t; using pg8::bf16x8; using pg8::f32x4; using pg8::u32x4;
typedef short bf16x4 __attribute__((ext_vector_type(4)));
typedef unsigned u32x2 __attribute__((ext_vector_type(2)));
typedef float f32x2v __attribute__((ext_vector_type(2)));
constexpr int NTOK = 12288, NPROMPT = 4096, DM = 1024;
constexpr int LDS_BYTES = 147456;
constexpr float EPSV = 1e-6f;
constexpr size_t WS_PROJ = 0;
constexpr size_t WS_YCAT = 176160768;
constexpr size_t WS_WIN  = WS_YCAT + 50331648;
constexpr size_t WS_WOUT = WS_WIN + 14680064;
constexpr size_t WS_STATS = WS_WOUT + 4194304;
constexpr size_t WS_MOD = WS_STATS + 3145728;
constexpr size_t WS_LB = WS_MOD + 245760;
constexpr size_t WS_BAR = WS_LB + 16384;
constexpr size_t WS_WIN2 = WS_BAR + 16384;
constexpr size_t WS_WOUT2 = WS_WIN2 + 14680064;
constexpr size_t WS_END = WS_WOUT2 + 4194304;
__device__ __forceinline__ size_t ws_win(int l) { return (l & 1) ? WS_WIN2 : WS_WIN; }
__device__ __forceinline__ size_t ws_wout(int l) { return (l & 1) ? WS_WOUT2 : WS_WOUT; }

struct Params {
    const float *x_prompt, *x_sample, *c, *state_hgrn, *c_ctx, *w_ada, *b_ada, *g_pre, *g_post, *w_in_ab, *w_out_ab, *lb_logits, *g_onorm, *w_pool, *pool_scale,
        *w_in_c, *w_out_c, *ln_g, *ln_b, *w_sp, *b_sp;
    float* out; unsigned char* ws;
};

__device__ __forceinline__ float bf2f(bf16_t b) { return __uint_as_float(((unsigned)b) << 16); }
__device__ __forceinline__ bf16_t f2bf(float f) { unsigned u = __float_as_uint(f); u += 0x7FFFu + ((u >> 16) & 1u); return (bf16_t)(u >> 16); }
__device__ __forceinline__ float silu_f(float x) { return x * __builtin_amdgcn_rcpf(1.f + __expf(-x)); }
__device__ __forceinline__ float wave_sum(float v) { v += __shfl_xor(v, 1); v += __shfl_xor(v, 2); v += __shfl_xor(v, 4); v += __shfl_xor(v, 8); v += __shfl_xor(v, 16); v += __shfl_xor(v, 32); return v; }

#define XB_TMO      128
#define XB_XCNT(j)  (256  + 64 * (j))
#define XB_XSUB(j)  (1280 + 64 * (j))
#define XB_XGEN(j)  (2304 + 64 * (j))
#define XB_TOP      3328
#define XB_TOPGEN   3392
#define XCD_BAR_WORDS 3456
#define XB_SPIN_CAP (1u << 20)
__device__ __forceinline__ unsigned xb_ld(unsigned* p)              { return __hip_atomic_load(p, __ATOMIC_RELAXED, __HIP_MEMORY_SCOPE_AGENT); }
__device__ __forceinline__ unsigned xb_add(unsigned* p, unsigned v) { return __hip_atomic_fetch_add(p, v, __ATOMIC_RELAXED, __HIP_MEMORY_SCOPE_AGENT); }
__device__ __forceinline__ unsigned xb_xcc_id() { return (unsigned)__builtin_amdgcn_s_getreg((3 << 11) | 20) & 0xFu; }
#define XB_SPIN(cond, bar) do { unsigned _sp = 0; while (cond) { __builtin_amdgcn_s_sleep(1); \
    if ((++_sp & 255u) == 0u) { if (xb_ld(&(bar)[XB_TMO])) break; if (_sp > XB_SPIN_CAP) { atomicAdd(&(bar)[XB_TMO], 1u); break; } } } } while (0)
struct XcdBarrier { unsigned* bar; unsigned x; volatile LAS unsigned* st; };
__device__ __forceinline__ XcdBarrier xcd_barrier_post(unsigned* bar, volatile LAS unsigned* st) {
    XcdBarrier b; b.bar = bar; b.x = xb_xcc_id(); b.st = st;
    if (threadIdx.x == 0) (void)xb_add(&bar[XB_XCNT(b.x)], 1u);
    return b;
}
__device__ __forceinline__ void xcd_barrier_complete(unsigned* bar, unsigned x, unsigned& nloc, unsigned& nx) {
    const unsigned G = gridDim.x * gridDim.y * gridDim.z;
    unsigned sum, cnt, mine, sp = 0u;
    for (;;) {
        sum = 0u; cnt = 0u; mine = 0u;
#pragma unroll
        for (unsigned j = 0; j < 16; ++j) { const unsigned c = xb_ld(&bar[XB_XCNT(j)]); sum += c; cnt += (c > 0u) ? 1u : 0u; mine = (j == x) ? c : mine; }
        if (sum == G) break;
        __builtin_amdgcn_s_sleep(1);
        if ((++sp & 255u) == 0u) { if (xb_ld(&bar[XB_TMO])) break; if (sp > XB_SPIN_CAP) { atomicAdd(&bar[XB_TMO], 1u); break; } }
    }
    nloc = mine > 0u ? mine : 1u; nx = cnt > 0u ? cnt : 1u;
}
__device__ __forceinline__ void xcd_barrier(const XcdBarrier& b) {
    asm volatile("s_waitcnt vmcnt(0)" ::: "memory");
    __syncthreads();
    if (threadIdx.x == 0) {
        unsigned* bar = b.bar;
        __builtin_amdgcn_s_waitcnt(0);
        unsigned nloc = b.st[0], nx = b.st[1];
        if (nloc == 0u) { xcd_barrier_complete(bar, b.x, nloc, nx); b.st[0] = nloc; b.st[1] = nx; }
        const unsigned old = xb_add(&bar[XB_XSUB(b.x)], 1u);
        const unsigned gen = old / nloc;
        if (old + 1u == (gen + 1u) * nloc) {
            __builtin_amdgcn_fence(__ATOMIC_RELEASE, "agent");
            asm volatile("s_waitcnt vmcnt(0)" ::: "memory");
            const unsigned og = xb_add(&bar[XB_TOP], 1u);
            const unsigned tg = og / nx;
            if (og + 1u == (tg + 1u) * nx) xb_add(&bar[XB_TOPGEN], 1u);
            else XB_SPIN(xb_ld(&bar[XB_TOPGEN]) == tg, bar);
            __builtin_amdgcn_fence(__ATOMIC_ACQUIRE, "agent");
            xb_add(&bar[XB_XGEN(b.x)], 1u);
            asm volatile("s_waitcnt vmcnt(0)" ::: "memory");
        } else {
            XB_SPIN(xb_ld(&bar[XB_XGEN(b.x)]) == gen, bar);
            __builtin_amdgcn_fence(__ATOMIC_ACQUIRE, "agent");
            asm volatile("s_waitcnt vmcnt(0)" ::: "memory");
        }
    }
    __syncthreads();
}

__device__ __forceinline__ void phase_mod(const Params& p, LAS unsigned char* lds) {
    int tid_l = threadIdx.x; asm volatile("" : "+v"(tid_l)); const int tid = tid_l;
    LAS float* sc = (LAS float*)lds;
    LAS float* red = sc + 5 * 1024;
    for (int i = tid; i < 5 * 1024; i += 512) { const int n = i >> 10, k = i & 1023; const float v = (n == 0) ? p.c_ctx[k] : p.c[(n - 1) * 1024 + k]; sc[i] = silu_f(v); }
    __syncthreads();
    float* mod = (float*)(p.ws + WS_MOD);
    for (int unit = blockIdx.x; unit < 192; unit += gridDim.x) {
        const int l = unit / 48, c0 = (unit % 48) * 64, cc = tid & 63, ks = tid >> 6;
        const float* w = p.w_ada + (size_t)l * 1024 * 3072 + c0 + cc;
        float a0 = 0.f, a1 = 0.f, a2 = 0.f, a3 = 0.f, a4 = 0.f;
#pragma unroll 8
        for (int k = ks * 128; k < ks * 128 + 128; ++k) { const float wv = __builtin_nontemporal_load(w + (size_t)k * 3072);
            a0 += sc[k] * wv; a1 += sc[1024 + k] * wv; a2 += sc[2048 + k] * wv; a3 += sc[3072 + k] * wv; a4 += sc[4096 + k] * wv; }
        LAS float* r = red + (ks * 64 + cc) * 5; r[0] = a0; r[1] = a1; r[2] = a2; r[3] = a3; r[4] = a4;
        __syncthreads();
        if (tid < 320) { const int c2 = tid & 63, n = tid >> 6; float s = 0.f;
#pragma unroll
            for (int k8 = 0; k8 < 8; ++k8) s += red[(k8 * 64 + c2) * 5 + n];
            mod[(size_t)(l * 5 + n) * 3072 + c0 + c2] = s + p.b_ada[l * 3072 + c0 + c2]; }
        __syncthreads();
    }
    float* LB = (float*)(p.ws + WS_LB);
    for (int i = blockIdx.x * 512 + tid; i < 2048; i += gridDim.x * 512) { const float l0 = p.lb_logits[i], l1 = p.lb_logits[2048 + i];
        LB[i] = 0.f; LB[2048 + i] = 1.f / (1.f + __expf(l0 - l1)); }
}

__device__ __forceinline__ void phase_row(const Params& p, int l) {
    int tid_l = threadIdx.x; asm volatile("" : "+v"(tid_l)); const int tid = tid_l, lane = tid & 63, wv = tid >> 6;
    const float* mod = (const float*)(p.ws + WS_MOD);
    const bf16_t* ybuf = (const bf16_t*)(p.ws + WS_PROJ);
    bf16_t* hbuf = (bf16_t*)(p.ws + WS_YCAT);
    const int rstep = gridDim.x * 8;
    for (int row0 = blockIdx.x * 8 + wv; row0 < NTOK; row0 += 2 * rstep) {
        int rows[2]; rows[0] = row0; rows[1] = (row0 + rstep < NTOK) ? row0 + rstep : row0;
        int nn[2]; f32x4 x[2][4], y[2][4];
#pragma unroll
        for (int q = 0; q < 2; ++q) { const int row = rows[q]; nn[q] = row < NPROMPT ? 0 : 1 + ((row - NPROMPT) >> 11);
            const float* xsrc = (l == 0) ? (row < NPROMPT ? p.x_prompt + (size_t)row * DM : p.x_sample + (size_t)(row - NPROMPT) * DM) : p.out + (size_t)row * DM;
#pragma unroll
            for (int i = 0; i < 4; ++i) x[q][i] = (l == 0) ? __builtin_nontemporal_load((const f32x4*)(xsrc + (i * 64 + lane) * 4)) : *(const f32x4*)(xsrc + (i * 64 + lane) * 4);
            if (l > 0) {
#pragma unroll
                for (int i = 0; i < 4; ++i) { const u32x2 yv = *(const u32x2*)(ybuf + (size_t)row * DM + (i * 64 + lane) * 4);
                    y[q][i] = (f32x4){__uint_as_float(yv.x << 16), __uint_as_float(yv.x & 0xffff0000u), __uint_as_float(yv.y << 16), __uint_as_float(yv.y & 0xffff0000u)}; } } }
        if (l > 0) {
            float ss[2];
#pragma unroll
            for (int q = 0; q < 2; ++q) { ss[q] = 0.f;
#pragma unroll
                for (int i = 0; i < 4; ++i) ss[q] += y[q][i][0] * y[q][i][0] + y[q][i][1] * y[q][i][1] + y[q][i][2] * y[q][i][2] + y[q][i][3] * y[q][i][3]; }
            ss[0] = wave_sum(ss[0]); ss[1] = wave_sum(ss[1]);
            const float* gp = p.g_post + (l - 1) * 1024;
#pragma unroll
            for (int q = 0; q < 2; ++q) { const float r = rsqrtf(ss[q] * (1.f / 1024.f) + EPSV); const float* gt = mod + (size_t)((l - 1) * 5 + nn[q]) * 3072 + 2048;
#pragma unroll
                for (int i = 0; i < 4; ++i) { const int col = (i * 64 + lane) * 4; const f32x4 g = *(const f32x4*)(gt + col), qq = *(const f32x4*)(gp + col); x[q][i] = x[q][i] + g * (y[q][i] * r * qq); } }
        }
#pragma unroll
        for (int q = 0; q < 2; ++q)
#pragma unroll
            for (int i = 0; i < 4; ++i) { f32x4* xp = (f32x4*)(p.out + (size_t)rows[q] * DM + (i * 64 + lane) * 4); if (l == 4) __builtin_nontemporal_store(x[q][i], xp); else *xp = x[q][i]; }
        if (l < 4) {
            float ss[2];
#pragma unroll
            for (int q = 0; q < 2; ++q) { ss[q] = 0.f;
#pragma unroll
                for (int i = 0; i < 4; ++i) ss[q] += x[q][i][0] * x[q][i][0] + x[q][i][1] * x[q][i][1] + x[q][i][2] * x[q][i][2] + x[q][i][3] * x[q][i][3]; }
            ss[0] = wave_sum(ss[0]); ss[1] = wave_sum(ss[1]);
            const float* gp = p.g_pre + l * 1024;
#pragma unroll
            for (int q = 0; q < 2; ++q) { const float r = rsqrtf(ss[q] * (1.f / 1024.f) + EPSV); const float* sh = mod + (size_t)(l * 5 + nn[q]) * 3072; const float* scl = sh + 1024;
#pragma unroll
                for (int i = 0; i < 4; ++i) { const int col = (i * 64 + lane) * 4; const f32x4 a = *(const f32x4*)(sh + col), sv = *(const f32x4*)(scl + col), g = *(const f32x4*)(gp + col);
                    const f32x4 hv = x[q][i] * r * g * (sv + 1.f) + a; u32x2 w; w.x = pg8::cvt_pk_bf16(hv[0], hv[1]); w.y = pg8::cvt_pk_bf16(hv[2], hv[3]);
                    *(u32x2*)(hbuf + (size_t)rows[q] * DM + col) = w; } }
        }
    }
}

__device__ __forceinline__ void conv_tile(const float* W, int K, int N, bf16_t* Wt, int kt, int nt, LAS unsigned char* lds) {
    int tid_l = threadIdx.x; asm volatile("" : "+v"(tid_l)); const int tid = tid_l; LAS float* tile = (LAS float*)lds;
    const int k0 = kt * 64, n0 = nt * 64;
#pragma unroll
    for (int it = 0; it < 2; ++it) { const int r = it * 32 + (tid >> 4), c4 = (tid & 15) * 4; const f32x4 v = __builtin_nontemporal_load((const f32x4*)(W + (size_t)(k0 + r) * N + n0 + c4));
        tile[r * 65 + c4] = v[0]; tile[r * 65 + c4 + 1] = v[1]; tile[r * 65 + c4 + 2] = v[2]; tile[r * 65 + c4 + 3] = v[3]; }
    __syncthreads();
    { const int nn = tid >> 3, k8 = (tid & 7) * 8; u32x4 w;
      w.x = pg8::cvt_pk_bf16(tile[(k8 + 0) * 65 + nn], tile[(k8 + 1) * 65 + nn]); w.y = pg8::cvt_pk_bf16(tile[(k8 + 2) * 65 + nn], tile[(k8 + 3) * 65 + nn]);
      w.z = pg8::cvt_pk_bf16(tile[(k8 + 4) * 65 + nn], tile[(k8 + 5) * 65 + nn]); w.w = pg8::cvt_pk_bf16(tile[(k8 + 6) * 65 + nn], tile[(k8 + 7) * 65 + nn]);
      *(u32x4*)(Wt + (size_t)(n0 + nn) * K + k0 + k8) = w; }
    __syncthreads();
}
__device__ __forceinline__ void fold_unit(const Params& p, int j, int fu, LAS unsigned char* lds, bf16_t* Wt) {
    int tid_l = threadIdx.x; asm volatile("" : "+v"(tid_l)); const int tid = tid_l; const int g = fu >> 5, et = (fu >> 3) & 3, kt = fu & 7; const int e0 = et * 64, k0 = kt * 128;
    LAS float* As = (LAS float*)lds;
    LAS float* Bs = As + 32 * 64;
    const float* wp = p.w_pool + (size_t)(j * 4 + g) * 65536; const float* wi = p.w_in_ab + (size_t)j * 1024 * 7168 + 5120 + g * 256;
    const int e4 = (tid & 15) * 4, k4 = (tid >> 4) * 4;
    float acc[4][4];
#pragma unroll
    for (int i = 0; i < 4; ++i)
#pragma unroll
        for (int q = 0; q < 4; ++q) acc[i][q] = 0.f;
    for (int c0 = 0; c0 < 256; c0 += 32) {
        { const int r = tid >> 4, c4 = (tid & 15) * 4; const f32x4 v = __builtin_nontemporal_load((const f32x4*)(wp + (size_t)(c0 + r) * 256 + e0 + c4)); *(LAS f32x4*)(As + r * 64 + c4) = v; }
        { const int kk = tid >> 2, cc = (tid & 3) * 8; const float* src = wi + (size_t)(k0 + kk) * 7168 + c0 + cc; const f32x4 v0 = *(const f32x4*)src, v1 = *(const f32x4*)(src + 4);
          LAS float* d = Bs + kk * 33 + cc; d[0] = v0[0]; d[1] = v0[1]; d[2] = v0[2]; d[3] = v0[3]; d[4] = v1[0]; d[5] = v1[1]; d[6] = v1[2]; d[7] = v1[3]; }
        __syncthreads();
#pragma unroll 8
        for (int c = 0; c < 32; ++c) { const f32x4 a = *(LAS f32x4*)(As + c * 64 + e4);
#pragma unroll
            for (int i = 0; i < 4; ++i) { const float bv = Bs[(k4 + i) * 33 + c]; acc[i][0] += bv * a[0]; acc[i][1] += bv * a[1]; acc[i][2] += bv * a[2]; acc[i][3] += bv * a[3]; } }
        __syncthreads();
    }
#pragma unroll
    for (int q = 0; q < 4; ++q) { const int e = g * 256 + e0 + e4 + q; const float ps = p.pool_scale[j * 1024 + e];
        u32x2 w; w.x = pg8::cvt_pk_bf16(acc[0][q] * ps, acc[1][q] * ps); w.y = pg8::cvt_pk_bf16(acc[2][q] * ps, acc[3][q] * ps);
        *(u32x2*)(Wt + (size_t)(5120 + e) * 1024 + k0 + k4) = w; }
}
__device__ __forceinline__ void conv_tile2(const float* W0, int K0, int N0, bf16_t* Wt0, int kt0, int nt0, const float* W1, int K1, int N1, bf16_t* Wt1, int kt1, int nt1, LAS unsigned char* lds) {
    int tid_l = threadIdx.x; asm volatile("" : "+v"(tid_l)); const int tid = tid_l; LAS float* tileA = (LAS float*)lds; LAS float* tileB = tileA + 64 * 65;
    f32x4 va[2], vb[2];
#pragma unroll
    for (int it = 0; it < 2; ++it) { const int r = it * 32 + (tid >> 4), c4 = (tid & 15) * 4;
        va[it] = __builtin_nontemporal_load((const f32x4*)(W0 + (size_t)(kt0 * 64 + r) * N0 + nt0 * 64 + c4)); vb[it] = __builtin_nontemporal_load((const f32x4*)(W1 + (size_t)(kt1 * 64 + r) * N1 + nt1 * 64 + c4)); }
#pragma unroll
    for (int it = 0; it < 2; ++it) { const int r = it * 32 + (tid >> 4), c4 = (tid & 15) * 4;
        tileA[r * 65 + c4] = va[it][0]; tileA[r * 65 + c4 + 1] = va[it][1]; tileA[r * 65 + c4 + 2] = va[it][2]; tileA[r * 65 + c4 + 3] = va[it][3];
        tileB[r * 65 + c4] = vb[it][0]; tileB[r * 65 + c4 + 1] = vb[it][1]; tileB[r * 65 + c4 + 2] = vb[it][2]; tileB[r * 65 + c4 + 3] = vb[it][3]; }
    __syncthreads();
    { const int nn = tid >> 3, k8 = (tid & 7) * 8; u32x4 w;
      w.x = pg8::cvt_pk_bf16(tileA[(k8 + 0) * 65 + nn], tileA[(k8 + 1) * 65 + nn]); w.y = pg8::cvt_pk_bf16(tileA[(k8 + 2) * 65 + nn], tileA[(k8 + 3) * 65 + nn]);
      w.z = pg8::cvt_pk_bf16(tileA[(k8 + 4) * 65 + nn], tileA[(k8 + 5) * 65 + nn]); w.w = pg8::cvt_pk_bf16(tileA[(k8 + 6) * 65 + nn], tileA[(k8 + 7) * 65 + nn]);
      *(u32x4*)(Wt0 + (size_t)(nt0 * 64 + nn) * K0 + kt0 * 64 + k8) = w;
      w.x = pg8::cvt_pk_bf16(tileB[(k8 + 0) * 65 + nn], tileB[(k8 + 1) * 65 + nn]); w.y = pg8::cvt_pk_bf16(tileB[(k8 + 2) * 65 + nn], tileB[(k8 + 3) * 65 + nn]);
      w.z = pg8::cvt_pk_bf16(tileB[(k8 + 4) * 65 + nn], tileB[(k8 + 5) * 65 + nn]); w.w = pg8::cvt_pk_bf16(tileB[(k8 + 6) * 65 + nn], tileB[(k8 + 7) * 65 + nn]);
      *(u32x4*)(Wt1 + (size_t)(nt1 * 64 + nn) * K1 + kt1 * 64 + k8) = w; }
    __syncthreads();
}
__device__ __forceinline__ void phase_conv(const Params& p, int l, LAS unsigned char* lds, int mode, int wid, int nw) {
    const int j = l >> 1; const bool ab = (l & 1) == 0;
    const float* Win = ab ? p.w_in_ab + (size_t)j * 1024 * 7168 : p.w_in_c + (size_t)j * 1024 * 6144; const int Nin = ab ? 7168 : 6144;
    const float* Wout = ab ? p.w_out_ab + (size_t)j * 2048 * 1024 : p.w_out_c + (size_t)j * 2048 * 1024;
    bf16_t* WtIn = (bf16_t*)(p.ws + ws_win(l)); bf16_t* WtOut = (bf16_t*)(p.ws + ws_wout(l));
    const int n_in = (mode == 2) ? 0 : 1536, n_out = (mode == 1) ? 0 : 512, n_fold = (ab && mode != 2) ? 128 : 0, n_t = n_in + n_out;
    for (int u = wid; u < n_t; u += 2 * nw) {
        const float* W0; int K0, N0, kt0, nt0; bf16_t* T0;
        if (u < n_in) { nt0 = u >> 4; kt0 = u & 15; if (ab && nt0 >= 80) nt0 += 16; W0 = Win; K0 = 1024; N0 = Nin; T0 = WtIn; } else { const int v = u - n_in; kt0 = v & 31; nt0 = v >> 5; W0 = Wout; K0 = 2048; N0 = 1024; T0 = WtOut; }
        const int u1 = u + nw;
        if (u1 < n_t) { const float* W1; int K1, N1, kt1, nt1; bf16_t* T1;
            if (u1 < n_in) { nt1 = u1 >> 4; kt1 = u1 & 15; if (ab && nt1 >= 80) nt1 += 16; W1 = Win; K1 = 1024; N1 = Nin; T1 = WtIn; } else { const int v = u1 - n_in; kt1 = v & 31; nt1 = v >> 5; W1 = Wout; K1 = 2048; N1 = 1024; T1 = WtOut; }
            conv_tile2(W0, K0, N0, T0, kt0, nt0, W1, K1, N1, T1, kt1, nt1, lds); }
        else conv_tile(W0, K0, N0, T0, kt0, nt0, lds);
    }
    for (int u = wid; u < n_fold; u += nw) fold_unit(p, j, u, lds, WtIn);
}

constexpr int HG_QS = 0, HG_KS = 8704, HG_KT = 17408, HG_VT = 27648, HG_FAC = 37888, HG_BUF = 39424, HG_TOT = 2 * HG_BUF, HG_PT = HG_TOT + 2048;
__device__ __forceinline__ float clampe(float v) { return fminf(fmaxf(v, -80.f), 80.f); }
__device__ __forceinline__ void hgrn_unit(const Params& p, LAS unsigned char* lds, int j, bool sample, int b, int h, int dir) {
    int tid_l = threadIdx.x; asm volatile("" : "+v"(tid_l)); const int tid = tid_l, lane = tid & 63, w = tid >> 6, fr = lane & 15, hq = lane >> 4;
    const int T = sample ? 2048 : 256, nch = T >> 5;
    const size_t rowbase = sample ? (size_t)NPROMPT + (size_t)b * 2048 : (size_t)b * 256;
    bf16_t* proj = (bf16_t*)(p.ws + WS_PROJ);
    const int d = tid & 127, tq = tid >> 7;
    const float lbv = ((const float*)(p.ws + WS_LB))[(j * 2 + dir) * 1024 + h * 128 + d], oml = 1.f - lbv;
    f32x4 S[8];
    if (sample) { const float* s0 = p.state_hgrn + ((((size_t)b * 2 + j) * 2 + dir) * 8 + h) * 16384;
#pragma unroll
        for (int dt = 0; dt < 8; ++dt)
#pragma unroll
            for (int r = 0; r < 4; ++r) S[dt][r] = __builtin_nontemporal_load(s0 + (16 * dt + 4 * hq + r) * 128 + 16 * w + fr);
    } else {
#pragma unroll
        for (int dt = 0; dt < 8; ++dt) S[dt] = (f32x4){0.f, 0.f, 0.f, 0.f};
    }
    LAS float* TOT = (LAS float*)(lds + HG_TOT);
    bf16_t nq[8], nf[8], nv[8];
    const size_t cq = (size_t)h * 128 + d, cf = 1024 * (1 + dir) + (size_t)h * 128 + d, cv = 3072 + (size_t)h * 128 + d;
    const long rstride = dir ? -7168 : 7168;
#define HG_LOAD(c) do { const int pi0 = (c) * 32 + 8 * tq; const bf16_t* rp = proj + (rowbase + (dir ? (T - 1 - pi0) : pi0)) * 7168; \
        _Pragma("unroll") for (int i = 0; i < 8; ++i) { nq[i] = rp[cq]; nf[i] = rp[cf]; nv[i] = rp[cv]; rp += rstride; } } while (0)
    HG_LOAD(0);
    for (int c = 0; c < nch; ++c) {
        LAS unsigned char* buf = lds + (c & 1) * HG_BUF;
        LAS bf16_t* QS = (LAS bf16_t*)(buf + HG_QS); LAS bf16_t* KS = (LAS bf16_t*)(buf + HG_KS); LAS bf16_t* KT = (LAS bf16_t*)(buf + HG_KT); LAS bf16_t* VT = (LAS bf16_t*)(buf + HG_VT);
        LAS float* FAC = (LAS float*)(buf + HG_FAC);
        float Pc[8], kk[8], qs[8]; float pr = 1.f;
#pragma unroll
        for (int i = 0; i < 8; ++i) { const float k = bf2f(nf[i]); kk[i] = k; pr *= fmaxf(1.f - k, 1e-3f); Pc[i] = pr;     qs[i] = bf2f(nq[i]); }
        const float cs = __logf(pr);
        TOT[tq * 128 + d] = cs;
        __syncthreads();
        const float t0 = TOT[d], t1 = TOT[128 + d], t2 = TOT[256 + d], t3 = TOT[384 + d];
        const float off = (tq > 0 ? t0 : 0.f) + (tq > 1 ? t1 : 0.f) + (tq > 2 ? t2 : 0.f);
        const float R = t0 + t1, Bl = R + t2 + t3;
        bf16_t kbs[8];
        const float ebase = __expf(clampe(off - R));
#pragma unroll
        for (int i = 0; i < 8; ++i) { const int tl = 8 * tq + i;
            const float eq = fminf(fmaxf(ebase * Pc[i], 1e-30f), 1e30f), ek = __builtin_amdgcn_rcpf(eq);
            const unsigned qk = pg8::cvt_pk_bf16(qs[i] * eq, kk[i] * ek); const bf16_t qb = (bf16_t)(qk & 0xffffu), kb = (bf16_t)(qk >> 16);
            QS[tl * 136 + d] = qb; KS[tl * 136 + d] = kb; kbs[i] = kb; }
        { u32x4 kw, vw; kw.x = (unsigned)kbs[0] | ((unsigned)kbs[1] << 16); kw.y = (unsigned)kbs[2] | ((unsigned)kbs[3] << 16); kw.z = (unsigned)kbs[4] | ((unsigned)kbs[5] << 16); kw.w = (unsigned)kbs[6] | ((unsigned)kbs[7] << 16);
          vw.x = (unsigned)nv[0] | ((unsigned)nv[1] << 16); vw.y = (unsigned)nv[2] | ((unsigned)nv[3] << 16); vw.z = (unsigned)nv[4] | ((unsigned)nv[5] << 16); vw.w = (unsigned)nv[6] | ((unsigned)nv[7] << 16);
          *(LAS u32x4*)(KT + d * 40 + 8 * tq) = kw; *(LAS u32x4*)(VT + d * 40 + 8 * tq) = vw; }
        if (tq == 0) { FAC[d] = __expf(R); FAC[128 + d] = __expf(Bl); FAC[256 + d] = __expf(Bl - R); }
        if (c + 1 < nch) HG_LOAD(c + 1);
        __syncthreads();
        LAS bf16_t* PT = (LAS bf16_t*)(lds + HG_PT);
        const int wu = __builtin_amdgcn_readfirstlane(w);
        if (wu < 3) { const int sb = (wu == 2) ? 1 : 0, tb = (wu >= 1) ? 1 : 0;
            f32x4 sc = {0.f, 0.f, 0.f, 0.f};
#pragma unroll
            for (int ks = 0; ks < 4; ++ks) {
                const bf16x8 a = *(LAS bf16x8*)(KS + (16 * sb + fr) * 136 + ks * 32 + hq * 8), bq = *(LAS bf16x8*)(QS + (16 * tb + fr) * 136 + ks * 32 + hq * 8);
                sc = __builtin_amdgcn_mfma_f32_16x16x32_bf16(a, bq, sc, 0, 0, 0); }
            if (wu != 1) {
#pragma unroll
                for (int r = 0; r < 4; ++r) sc[r] = (fr >= 4 * hq + r) ? sc[r] : 0.f; }
            else {
#pragma unroll
                for (int r = 0; r < 4; ++r) sc[r] = sc[r] + 0.f; }
            u32x2 pk; pk.x = pg8::cvt_pk_bf16(sc[0], sc[1]); pk.y = pg8::cvt_pk_bf16(sc[2], sc[3]);
            *(LAS u32x2*)(PT + (tb * 16 + fr) * 40 + 16 * sb + 4 * hq) = pk;
        } else if (wu == 3) { u32x2 z; z.x = 0u; z.y = 0u; *(LAS u32x2*)(PT + fr * 40 + 16 + 4 * hq) = z; }
        const LAS bf16_t* vrow = VT + (16 * w + fr) * 40;
        f32x4 o0 = {0.f, 0.f, 0.f, 0.f}, o1 = o0;
#pragma unroll
        for (int ks = 0; ks < 4; ++ks) {
            const f32x4 e0 = *(LAS f32x4*)(FAC + 32 * ks + 4 * hq), e1 = *(LAS f32x4*)(FAC + 32 * ks + 16 + 4 * hq);
            const f32x4 x0 = S[2 * ks] * e0, x1 = S[2 * ks + 1] * e1;
            u32x4 sb; sb.x = pg8::cvt_pk_bf16(x0[0], x0[1]); sb.y = pg8::cvt_pk_bf16(x0[2], x0[3]); sb.z = pg8::cvt_pk_bf16(x1[0], x1[1]); sb.w = pg8::cvt_pk_bf16(x1[2], x1[3]);
            const LAS bf16_t* q0 = QS + fr * 136 + 32 * ks + 4 * hq; const LAS bf16_t* q1 = q0 + 16 * 136;
            u32x4 qa0, qa1; { const u32x2 lo = *(const LAS u32x2*)q0, hi = *(const LAS u32x2*)(q0 + 16); qa0.x = lo.x; qa0.y = lo.y; qa0.z = hi.x; qa0.w = hi.y; }
            { const u32x2 lo = *(const LAS u32x2*)q1, hi = *(const LAS u32x2*)(q1 + 16); qa1.x = lo.x; qa1.y = lo.y; qa1.z = hi.x; qa1.w = hi.y; }
            o0 = __builtin_amdgcn_mfma_f32_16x16x32_bf16(__builtin_bit_cast(bf16x8, qa0), __builtin_bit_cast(bf16x8, sb), o0, 0, 0, 0);
            o1 = __builtin_amdgcn_mfma_f32_16x16x32_bf16(__builtin_bit_cast(bf16x8, qa1), __builtin_bit_cast(bf16x8, sb), o1, 0, 0, 0);
        }
        { const bf16x8 vb8 = *(const LAS bf16x8*)(vrow + 8 * hq);
#pragma unroll
          for (int dt = 0; dt < 8; ++dt) {
              const bf16x8 ka = *(const LAS bf16x8*)(KT + (16 * dt + fr) * 40 + 8 * hq);
              f32x4 t = {0.f, 0.f, 0.f, 0.f};
              t = __builtin_amdgcn_mfma_f32_16x16x32_bf16(ka, vb8, t, 0, 0, 0);
              const f32x4 el = *(LAS f32x4*)(FAC + 128 + 16 * dt + 4 * hq), er = *(LAS f32x4*)(FAC + 256 + 16 * dt + 4 * hq);
              S[dt] = S[dt] * el + er * t;
          } }
        __syncthreads();
        { u32x4 pa0, pa1, vb;
          { const LAS bf16_t* p0 = PT + fr * 40 + 4 * hq; const u32x2 lo = *(const LAS u32x2*)p0, hi = *(const LAS u32x2*)(p0 + 16); pa0.x = lo.x; pa0.y = lo.y; pa0.z = hi.x; pa0.w = hi.y; }
          { const LAS bf16_t* p1 = PT + (16 + fr) * 40 + 4 * hq; const u32x2 lo = *(const LAS u32x2*)p1, hi = *(const LAS u32x2*)(p1 + 16); pa1.x = lo.x; pa1.y = lo.y; pa1.z = hi.x; pa1.w = hi.y; }
          { const u32x2 lo = *(const LAS u32x2*)(vrow + 4 * hq), hi = *(const LAS u32x2*)(vrow + 16 + 4 * hq); vb.x = lo.x; vb.y = lo.y; vb.z = hi.x; vb.w = hi.y; }
          o0 = __builtin_amdgcn_mfma_f32_16x16x32_bf16(__builtin_bit_cast(bf16x8, pa0), __builtin_bit_cast(bf16x8, vb), o0, 0, 0, 0);
          o1 = __builtin_amdgcn_mfma_f32_16x16x32_bf16(__builtin_bit_cast(bf16x8, pa1), __builtin_bit_cast(bf16x8, vb), o1, 0, 0, 0); }
        { const int pi0 = c * 32 + 4 * hq; bf16_t* op = proj + (rowbase + (dir ? (T - 1 - pi0) : pi0)) * 7168 + 1024 * (1 + dir) + h * 128 + 16 * w + fr;
#pragma unroll
          for (int r = 0; r < 4; ++r) { op[0] = f2bf(o0[r]); op[16 * rstride] = f2bf(o1[r]); op += rstride; } }
    }
#undef HG_LOAD
    if (!sample) { float* so = p.out + (size_t)NTOK * DM + ((((size_t)b * 2 + j) * 2 + dir) * 8 + h) * 16384;
#pragma unroll
        for (int dt = 0; dt < 8; ++dt)
#pragma unroll
            for (int r = 0; r < 4; ++r) __builtin_nontemporal_store(S[dt][r], so + (16 * dt + 4 * hq + r) * 128 + 16 * w + fr);
    }
    __syncthreads();
}

template <int W> __device__ __forceinline__ void pool_prompt_unit(const Params& p, int b, int slab) {
    int tid_l = threadIdx.x; asm volatile("" : "+v"(tid_l)); const int tid = tid_l, cp = tid & 31, seg = tid >> 5; const int ch = slab * 64 + 2 * cp, t0 = seg * 16;
    const bf16_t* proj = (const bf16_t*)(p.ws + WS_PROJ); bf16_t* ycat = (bf16_t*)(p.ws + WS_YCAT);
    float xa[16 + W], xb[16 + W];
#pragma unroll
    for (int i = 0; i < 16 + W; ++i) { const int t = t0 - W / 2 + i; float a = 0.f, bq = 0.f;
        if (t >= 0 && t < 256) { const unsigned v = *(const unsigned*)(proj + ((size_t)b * 256 + t) * 7168 + 5120 + ch); a = __uint_as_float(v << 16); bq = __uint_as_float(v & 0xffff0000u); }
        xa[i] = a; xb[i] = bq; }
    unsigned gvs[16];
#pragma unroll
    for (int k = 0; k < 16; ++k) gvs[k] = *(const unsigned*)(proj + ((size_t)b * 256 + t0 + k) * 7168 + 6144 + ch);
#pragma unroll
    for (int k = 0; k < 16; ++k) { const int t = t0 + k; float sa = 0.f, sb = 0.f;
#pragma unroll
        for (int i = 0; i < W; ++i) { sa += xa[k + i]; sb += xb[k + i]; }
        const int lo = max(t - W / 2, 0), hi = min(t - W / 2 + W, 256); const float inv = __builtin_amdgcn_rcpf((float)(hi - lo));
        const size_t row = (size_t)b * 256 + t; const unsigned gv = gvs[k];
        const float ya = (sa * inv - xa[k + W / 2]) * silu_f(__uint_as_float(gv << 16)), yb = (sb * inv - xb[k + W / 2]) * silu_f(__uint_as_float(gv & 0xffff0000u));
        *(unsigned*)(ycat + row * 2048 + 1024 + ch) = pg8::cvt_pk_bf16(ya, yb); }
}
template <int W> __device__ __forceinline__ void pool_sample_unit(const Params& p, LAS unsigned char* lds, int b, int g, int slab) {
    int tid_l = threadIdx.x; asm volatile("" : "+v"(tid_l)); const int tid = tid_l; const int chb = g * 256 + slab * 16;
    const bf16_t* proj = (const bf16_t*)(p.ws + WS_PROJ); bf16_t* ycat = (bf16_t*)(p.ws + WS_YCAT);
    LAS float* buf = (LAS float*)lds;
    const size_t rowb = (size_t)NPROMPT + (size_t)b * 2048;
    { const int cp = tid & 7, col = tid >> 3; float pa[33], pb[33]; pa[0] = 0.f; pb[0] = 0.f;
#pragma unroll
      for (int r = 0; r < 32; ++r) { const unsigned v = *(const unsigned*)(proj + (rowb + r * 64 + col) * 7168 + 5120 + chb + 2 * cp);
          pa[r + 1] = pa[r] + __uint_as_float(v << 16); pb[r + 1] = pb[r] + __uint_as_float(v & 0xffff0000u); }
#pragma unroll
      for (int r = 0; r < 32; ++r) { const int lo = (r - W / 2) > 0 ? (r - W / 2) : 0, hi = (r - W / 2 + W) < 32 ? (r - W / 2 + W) : 32; const float inv = 1.f / (float)(hi - lo);
          LAS float* dst = buf + r * 1040 + col * 16 + 2 * cp; dst[0] = (pa[hi] - pa[lo]) * inv; dst[1] = (pb[hi] - pb[lo]) * inv; } }
    __syncthreads();
    { const int chl = tid & 15, r = tid >> 4; float pc[65]; pc[0] = 0.f;
#pragma unroll
      for (int col = 0; col < 64; ++col) pc[col + 1] = pc[col] + buf[r * 1040 + col * 16 + chl];
#pragma unroll
      for (int cb = 0; cb < 2; ++cb) { bf16_t zz[32], gg[32];
#pragma unroll
          for (int c2 = 0; c2 < 32; ++c2) { const size_t row = rowb + r * 64 + cb * 32 + c2; zz[c2] = proj[row * 7168 + 5120 + chb + chl]; gg[c2] = proj[row * 7168 + 6144 + chb + chl]; }
#pragma unroll
          for (int c2 = 0; c2 < 32; ++c2) { const int col = cb * 32 + c2; const int lo = (col - W / 2) > 0 ? (col - W / 2) : 0, hi = (col - W / 2 + W) < 64 ? (col - W / 2 + W) : 64; const float inv = 1.f / (float)(hi - lo);
              const size_t row = rowb + r * 64 + col;
              ycat[row * 2048 + 1024 + chb + chl] = f2bf(((pc[hi] - pc[lo]) * inv - bf2f(zz[c2])) * silu_f(bf2f(gg[c2]))); } } }
    __syncthreads();
}

__device__ __forceinline__ void pool_unit(const Params& p, LAS unsigned char* lds, int u) {
    if (u < 64) { const int b = u >> 4, g = (u >> 2) & 3, sq = u & 3;
        for (int s4 = 0; s4 < 4; ++s4) { const int slab = sq * 4 + s4;
            if (g == 0) pool_sample_unit<2>(p, lds, b, g, slab); else if (g == 1) pool_sample_unit<4>(p, lds, b, g, slab); else if (g == 2) pool_sample_unit<8>(p, lds, b, g, slab); else pool_sample_unit<16>(p, lds, b, g, slab); } }
    else { const int v = u - 64, b = v >> 4, slab = v & 15, g = slab >> 2;
        if (g == 0) pool_prompt_unit<2>(p, b, slab); else if (g == 1) pool_prompt_unit<4>(p, b, slab); else if (g == 2) pool_prompt_unit<8>(p, b, slab); else pool_prompt_unit<16>(p, b, slab); }
}
__device__ __forceinline__ void phase_mix_ab(const Params& p, int j, int l_next, LAS unsigned char* lds) {
    const int bid = blockIdx.x, G = gridDim.x;
    if (G >= 128) {
        if (bid < 64) { hgrn_unit(p, lds, j, true, bid >> 4, (bid >> 1) & 7, bid & 1); return; }
        const int idx = bid - 64, nS = G - 64;
        for (int v = idx; v < 256; v += nS) hgrn_unit(p, lds, j, false, v >> 4, (v >> 1) & 7, v & 1);
        for (int u = nS - 1 - idx; u < 320; u += nS) pool_unit(p, lds, u);
        if (l_next < 4) phase_conv(p, l_next, lds, 0, idx, nS);
        if (l_next + 1 < 4) phase_conv(p, l_next + 1, lds, 1, idx, nS);
    } else {
        for (int u = bid; u < 320; u += G) { if (u < 64) hgrn_unit(p, lds, j, true, u >> 4, (u >> 1) & 7, u & 1); else { const int v = u - 64; hgrn_unit(p, lds, j, false, v >> 4, (v >> 1) & 7, v & 1); } }
        for (int u = bid; u < 320; u += G) pool_unit(p, lds, u);
        if (l_next < 4) phase_conv(p, l_next, lds, 0, bid, G);
        if (l_next + 1 < 4) phase_conv(p, l_next + 1, lds, 1, bid, G);
    }
}
__device__ __forceinline__ void phase_combine(const Params& p, int j) {
    int tid_l = threadIdx.x; asm volatile("" : "+v"(tid_l)); const int tid = tid_l, lane = tid & 63, wv = tid >> 6; const int hd = lane >> 3, e0 = (lane & 7) * 16;
    const bf16_t* proj = (const bf16_t*)(p.ws + WS_PROJ); bf16_t* ycat = (bf16_t*)(p.ws + WS_YCAT);
    float gn[16];
#pragma unroll
    for (int i = 0; i < 16; ++i) gn[i] = p.g_onorm[j * 128 + e0 + i];
    for (int tok = blockIdx.x * 8 + wv; tok < NTOK; tok += gridDim.x * 8) {
        const bf16_t* rp = proj + (size_t)tok * 7168 + hd * 128 + e0;
        const u32x4 f0 = *(const u32x4*)(rp + 1024), f1 = *(const u32x4*)(rp + 1024 + 8), b0 = *(const u32x4*)(rp + 2048), b1 = *(const u32x4*)(rp + 2048 + 8), g0 = *(const u32x4*)(rp + 4096), g1 = *(const u32x4*)(rp + 4096 + 8);
        float s[16], gt[16]; float ss = 0.f;
#pragma unroll
        for (int i = 0; i < 4; ++i) { s[2 * i] = __uint_as_float(f0[i] << 16) + __uint_as_float(b0[i] << 16); s[2 * i + 1] = __uint_as_float(f0[i] & 0xffff0000u) + __uint_as_float(b0[i] & 0xffff0000u);
            s[8 + 2 * i] = __uint_as_float(f1[i] << 16) + __uint_as_float(b1[i] << 16); s[8 + 2 * i + 1] = __uint_as_float(f1[i] & 0xffff0000u) + __uint_as_float(b1[i] & 0xffff0000u);
            gt[2 * i] = __uint_as_float(g0[i] << 16); gt[2 * i + 1] = __uint_as_float(g0[i] & 0xffff0000u); gt[8 + 2 * i] = __uint_as_float(g1[i] << 16); gt[8 + 2 * i + 1] = __uint_as_float(g1[i] & 0xffff0000u); }
#pragma unroll
        for (int i = 0; i < 16; ++i) ss += s[i] * s[i];
        ss += __shfl_xor(ss, 1); ss += __shfl_xor(ss, 2); ss += __shfl_xor(ss, 4);
        const float r = rsqrtf(ss * (1.f / 128.f) + EPSV);
        u32x4 w0, w1;
#pragma unroll
        for (int i = 0; i < 4; ++i) { w0[i] = pg8::cvt_pk_bf16(s[2 * i] * r * gn[2 * i] * silu_f(gt[2 * i]), s[2 * i + 1] * r * gn[2 * i + 1] * silu_f(gt[2 * i + 1]));
            w1[i] = pg8::cvt_pk_bf16(s[8 + 2 * i] * r * gn[8 + 2 * i] * silu_f(gt[8 + 2 * i]), s[8 + 2 * i + 1] * r * gn[8 + 2 * i + 1] * silu_f(gt[8 + 2 * i + 1])); }
        bf16_t* yp = ycat + (size_t)tok * 2048 + hd * 128 + e0; *(u32x4*)yp = w0; *(u32x4*)(yp + 8) = w1;
    }
}

constexpr int CM_VNT = 0, CM_WS = 69632, CM_MU = 104448;
__device__ __forceinline__ void phase_mix_c(const Params& p, int j, LAS unsigned char* lds) {
    int tid_l = threadIdx.x; asm volatile("" : "+v"(tid_l)); const int tid = tid_l, lane = tid & 63, w = tid >> 6, fr = lane & 15, hq = lane >> 4;
    const bf16_t* proj = (const bf16_t*)(p.ws + WS_PROJ); bf16_t* ycat = (bf16_t*)(p.ws + WS_YCAT); const float* stats = (const float*)(p.ws + WS_STATS);
    LAS bf16_t* VNT = (LAS bf16_t*)(lds + CM_VNT); LAS bf16_t* WSL = (LAS bf16_t*)(lds + CM_WS); LAS f32x2v* MU = (LAS f32x2v*)(lds + CM_MU);
    for (int unit = blockIdx.x; unit < 768; unit += gridDim.x) {
        const int g = unit & 7, n = unit >> 3; const size_t row0 = (size_t)n * 128;
        u32x4 va[4], vb[4];
        { const int sp_ = tid >> 3, cg_ = (tid & 7) * 32; const bf16_t* s0_ = proj + (row0 + 2 * sp_) * 6144 + 2048 + g * 256 + cg_;
#pragma unroll
          for (int i = 0; i < 4; ++i) { va[i] = *(const u32x4*)(s0_ + 8 * i); vb[i] = *(const u32x4*)(s0_ + 6144 + 8 * i); } }
        if (tid < 128) { float s = 0.f, q = 0.f;
#pragma unroll
            for (int i = 0; i < 8; ++i) { const float* sp = stats + ((size_t)i * NTOK + row0 + tid) * 8; const f32x4 v = *(const f32x4*)sp, v2 = *(const f32x4*)(sp + 4); s += (v[0] + v[2]) + (v2[0] + v2[2]); q += (v[1] + v[3]) + (v2[1] + v2[3]); }
            const float mean = s * (1.f / 2048.f); const float var = fmaxf(q * (1.f / 2048.f) - mean * mean, 0.f); MU[tid] = (f32x2v){mean, rsqrtf(var + EPSV)}; }
        if (unit == (int)blockIdx.x || (gridDim.x & 7) != 0)
        { const int t = tid >> 2, s0 = (tid & 3) * 32; const float* src = p.w_sp + ((size_t)(j * 8 + g) * 128 + t) * 128 + s0;
#pragma unroll
          for (int i = 0; i < 4; ++i) { const f32x4 a = *(const f32x4*)(src + 8 * i), bq = *(const f32x4*)(src + 8 * i + 4);
              u32x4 wv; wv.x = pg8::cvt_pk_bf16(a[0], a[1]); wv.y = pg8::cvt_pk_bf16(a[2], a[3]); wv.z = pg8::cvt_pk_bf16(bq[0], bq[1]); wv.w = pg8::cvt_pk_bf16(bq[2], bq[3]);
              *(LAS u32x4*)(WSL + t * 136 + s0 + 8 * i) = wv; } }
        __syncthreads();
        { const int sp = tid >> 3, cg = (tid & 7) * 32; const f32x2v m0 = MU[2 * sp], m1 = MU[2 * sp + 1];
          const bf16_t* s0 = proj + (row0 + 2 * sp) * 6144 + 2048 + g * 256 + cg; const bf16_t* s1 = s0 + 6144;
          const float* lg = p.ln_g + j * 2048 + g * 256 + cg; const float* lb = p.ln_b + j * 2048 + g * 256 + cg;
#pragma unroll
          for (int i = 0; i < 4; ++i) { const f32x4 g0 = *(const f32x4*)(lg + 8 * i), g1 = *(const f32x4*)(lg + 8 * i + 4), b0 = *(const f32x4*)(lb + 8 * i), b1 = *(const f32x4*)(lb + 8 * i + 4);
#pragma unroll
              for (int q = 0; q < 4; ++q) { const int c = cg + 8 * i + 2 * q; const float ga = (q < 2) ? g0[2 * q] : g1[2 * q - 4], gb = (q < 2) ? g0[2 * q + 1] : g1[2 * q - 3], ba = (q < 2) ? b0[2 * q] : b1[2 * q - 4], bb = (q < 2) ? b0[2 * q + 1] : b1[2 * q - 3];
                  const float x00 = __uint_as_float(va[i][q] << 16), x01 = __uint_as_float(va[i][q] & 0xffff0000u), x10 = __uint_as_float(vb[i][q] << 16), x11 = __uint_as_float(vb[i][q] & 0xffff0000u);
                  *(LAS unsigned*)(VNT + c * 136 + 2 * sp) = pg8::cvt_pk_bf16((x00 - m0.x) * m0.y * ga + ba, (x10 - m1.x) * m1.y * ga + ba);
                  *(LAS unsigned*)(VNT + (c + 1) * 136 + 2 * sp) = pg8::cvt_pk_bf16((x01 - m0.x) * m0.y * gb + bb, (x11 - m1.x) * m1.y * gb + bb); } } }
        __syncthreads();
        bf16x8 af[2][4];
#pragma unroll
        for (int ct = 0; ct < 2; ++ct)
#pragma unroll
            for (int ks = 0; ks < 4; ++ks) af[ct][ks] = *(const LAS bf16x8*)(VNT + (32 * w + 8 * (fr >> 2) + 4 * ct + (fr & 3)) * 136 + 32 * ks + 8 * hq);
        const float* bsp = p.b_sp + (size_t)(j * 8 + g) * 128;
        f32x4 acc[8][2];
#pragma unroll
        for (int tt = 0; tt < 8; ++tt) {
            f32x4 a0 = {0.f, 0.f, 0.f, 0.f}, a1 = a0;
#pragma unroll
            for (int ks = 0; ks < 4; ++ks) { const bf16x8 bf = *(const LAS bf16x8*)(WSL + (16 * tt + fr) * 136 + 32 * ks + 8 * hq);
                a0 = __builtin_amdgcn_mfma_f32_16x16x32_bf16(af[0][ks], bf, a0, 0, 0, 0); a1 = __builtin_amdgcn_mfma_f32_16x16x32_bf16(af[1][ks], bf, a1, 0, 0, 0); }
            acc[tt][0] = a0; acc[tt][1] = a1;
        }
#pragma unroll
        for (int tb = 0; tb < 2; ++tb) {
            u32x4 uu[4], gg[4]; float bs[4]; const int c = g * 256 + 32 * w + 8 * hq;
#pragma unroll
            for (int t4 = 0; t4 < 4; ++t4) { const int tt = tb * 4 + t4; const size_t row = row0 + 16 * tt + fr; bs[t4] = bsp[16 * tt + fr];
                uu[t4] = *(const u32x4*)(proj + row * 6144 + c); gg[t4] = *(const u32x4*)(proj + row * 6144 + 4096 + c); }
#pragma unroll
            for (int t4 = 0; t4 < 4; ++t4) { const int tt = tb * 4 + t4; const size_t row = row0 + 16 * tt + fr; const float bq = bs[t4]; u32x4 o;
#pragma unroll
                for (int ct = 0; ct < 2; ++ct) { const f32x4 a = acc[tt][ct]; const unsigned ux = uu[t4][2 * ct], uy = uu[t4][2 * ct + 1], gx = gg[t4][2 * ct], gy = gg[t4][2 * ct + 1];
                    const float y0 = __uint_as_float(ux << 16) * (a[0] + bq) * silu_f(__uint_as_float(gx << 16)), y1 = __uint_as_float(ux & 0xffff0000u) * (a[1] + bq) * silu_f(__uint_as_float(gx & 0xffff0000u));
                    const float y2 = __uint_as_float(uy << 16) * (a[2] + bq) * silu_f(__uint_as_float(gy << 16)), y3 = __uint_as_float(uy & 0xffff0000u) * (a[3] + bq) * silu_f(__uint_as_float(gy & 0xffff0000u));
                    o[2 * ct] = pg8::cvt_pk_bf16(y0, y1); o[2 * ct + 1] = pg8::cvt_pk_bf16(y2, y3); }
                *(u32x4*)(ycat + row * 2048 + c) = o; }
        }
        __syncthreads();
    }
}

#ifdef DIAG_L
__device__ __forceinline__ void diag_dump_bf16(const Params& p, const bf16_t* buf, int K) {
    for (size_t i = (size_t)blockIdx.x * 512 + threadIdx.x; i < (size_t)NTOK * DM; i += (size_t)gridDim.x * 512) { float a = 0.f; for (int k = 0; k < K; ++k) a += bf2f(buf[i + (size_t)k * NTOK * DM]); p.out[i] = (float)((__float_as_uint(a) * 2654435761u) >> 16) * (1.f / 65536.f); }
}
__device__ __forceinline__ void diag_dump_f32(const Params& p, const float* buf) {
    for (size_t i = (size_t)blockIdx.x * 512 + threadIdx.x; i < (size_t)NTOK * DM; i += (size_t)gridDim.x * 512) p.out[i] = (float)((__float_as_uint(buf[i]) * 2654435761u) >> 16) * (1.f / 65536.f);
}
#endif
__global__ void __launch_bounds__(512, 2) mega_fwd(Params p) {
    extern __shared__ __attribute__((aligned(16))) unsigned char shm[];
    LAS unsigned char* lds = (LAS unsigned char*)shm;
    volatile LAS unsigned* bst = (volatile LAS unsigned*)(lds + LDS_BYTES - 16);
    if (threadIdx.x < 4) bst[threadIdx.x] = 0u;
    __syncthreads();
    XcdBarrier bar = xcd_barrier_post((unsigned*)(p.ws + WS_BAR), bst);
    phase_mod(p, lds);
    cg::this_grid().sync();
    xcd_barrier(bar);
    bf16_t* hbuf = (bf16_t*)(p.ws + WS_YCAT); bf16_t* ycat = hbuf; bf16_t* projb = (bf16_t*)(p.ws + WS_PROJ);
#ifdef DIAG_MOD
    { const float* md = (const float*)(p.ws + WS_MOD);
      for (size_t i = (size_t)blockIdx.x * 512 + threadIdx.x; i < (size_t)NTOK * DM; i += (size_t)gridDim.x * 512) p.out[i] = i < 61440 ? md[i] : 0.f;
      return; }
#endif
    for (int l = 0; l < 4; ++l) {
        const int j = l >> 1; const bool ab = (l & 1) == 0;
        phase_row(p, l);
#ifdef DIAG_STOP_LAYER
        if (l == DIAG_STOP_LAYER) {
#ifdef DIAG_BITS
            xcd_barrier(bar);
            for (size_t i = (size_t)blockIdx.x * 512 + threadIdx.x; i < (size_t)NTOK * DM; i += (size_t)gridDim.x * 512) { const unsigned u = __float_as_uint(p.out[i]); p.out[i] = (float)((u * 2654435761u) >> 16) * (1.f / 65536.f); }
#endif
#ifdef DIAG_MOD2
            xcd_barrier(bar);
            { const float* md = (const float*)(p.ws + WS_MOD);
              for (size_t i = (size_t)blockIdx.x * 512 + threadIdx.x; i < (size_t)NTOK * DM; i += (size_t)gridDim.x * 512) p.out[i] = i < 61440 ? md[i] : 0.f; }
#endif
            return; }
#endif
        if (l == 0) phase_conv(p, 0, lds, 0, (int)blockIdx.x, (int)gridDim.x);
        else if (l == 2) phase_conv(p, 2, lds, 2, (int)blockIdx.x, (int)gridDim.x);
        xcd_barrier(bar);
#ifdef DIAG_L
        if (l == DIAG_L && DIAG_S == 0) { unsigned* hb = (unsigned*)hbuf;
            for (size_t i = (size_t)blockIdx.x * 512 + threadIdx.x; i < (size_t)NTOK * DM / 2; i += (size_t)gridDim.x * 512) { const unsigned v = __hip_atomic_load(hb + i, __ATOMIC_RELAXED, __HIP_MEMORY_SCOPE_AGENT);
                p.out[2 * i] = __uint_as_float(v << 16); p.out[2 * i + 1] = __uint_as_float(v & 0xffff0000u); }
            return; }
#endif
        { pg8::StaticOrder S; pg8::Gemm g; g.A = hbuf; g.Bt = (const bf16_t*)(p.ws + ws_win(l)); g.M = NTOK; g.K = 1024;
          if (ab) { g.N = 7168; S.init(g.M, g.N, (int)gridDim.x, (int)blockIdx.x); pg8::EpiBf16S E; E.O = projb; E.ldc = 7168; E.stats = nullptr; E.st_lo = 0; E.st_hi = 0; E.sl_hi = 4; E.kg_hi = 12; E.lbp = (const float*)(p.ws + WS_LB) + j * 2048;
              pg8::gemm_phase<pg8::EpiBf16S, pg8::StaticOrder, false>(lds, g, S, E, nullptr); }
          else { g.N = 6144; S.init(g.M, g.N, (int)gridDim.x, (int)blockIdx.x); pg8::EpiBf16S E; E.O = projb; E.ldc = 6144; E.stats = (float*)(p.ws + WS_STATS); E.st_lo = 8; E.st_hi = 16; E.sl_hi = 0; E.kg_hi = 0; E.lbp = nullptr;
              pg8::gemm_phase<pg8::EpiBf16S, pg8::StaticOrder, false>(lds, g, S, E, nullptr); } }
        xcd_barrier(bar);
#ifdef DIAG_L
        if (l == DIAG_L && DIAG_S == 1) { diag_dump_bf16(p, projb, ab ? 7 : 6); return; }
#endif
        if (ab) { phase_mix_ab(p, j, l + 1, lds); xcd_barrier(bar); phase_combine(p, j); }
        else phase_mix_c(p, j, lds);
        xcd_barrier(bar);
#ifdef DIAG_L
        if (l == DIAG_L && DIAG_S == 2) { diag_dump_bf16(p, ycat, 2); return; }
        if (l == DIAG_L && DIAG_S == 4) {
            for (size_t i = (size_t)blockIdx.x * 512 + threadIdx.x; i < (size_t)NTOK * DM; i += (size_t)gridDim.x * 512) { const size_t rr = i >> 10; const float a = (rr >= DIAG_R0 && rr < DIAG_R1) ? bf2f(ycat[rr * 2048 + (i & 1023) + DIAG_HALF * 1024]) : 0.f;
                p.out[i] = (float)((__float_as_uint(a) * 2654435761u) >> 16) * (1.f / 65536.f); }
            return; }
#endif
        { pg8::StaticOrder S; pg8::Gemm g; g.A = ycat; g.Bt = (const bf16_t*)(p.ws + ws_wout(l)); g.M = NTOK; g.N = 1024; g.K = 2048; S.init(g.M, g.N, (int)gridDim.x, (int)blockIdx.x);
          pg8::EpiBf16S E; E.O = projb; E.ldc = 1024; E.stats = nullptr; E.st_lo = 0; E.st_hi = 0; E.sl_hi = 0; E.kg_hi = 0; E.lbp = nullptr;
          pg8::gemm_phase<pg8::EpiBf16S, pg8::StaticOrder, false>(lds, g, S, E, nullptr); }
        xcd_barrier(bar);
#ifdef DIAG_L
        if (l == DIAG_L && DIAG_S == 3) { diag_dump_f32(p, (const float*)(p.ws + WS_PROJ)); return; }
#endif
    }
    phase_row(p, 4);
}

extern "C" void kernel_launch(void* const* d_in, const int* in_sizes, int n_in, void* d_out, int out_size, void* d_ws, size_t ws_size, hipStream_t stream) {
    static int grid = 0;
    if (grid == 0) {
        if (n_in != 21 || ws_size < WS_END) { fprintf(stderr, "kernel_launch: unexpected n_in %d / ws_size %zu (need %zu)\n", n_in, ws_size, (size_t)WS_END); grid = -1; return; }
        int dev = 0, cus = 0, per_cu = 0;
        hipGetDevice(&dev); hipDeviceGetAttribute(&cus, hipDeviceAttributeMultiprocessorCount, dev);
        if (hipFuncSetAttribute((const void*)mega_fwd, hipFuncAttributeMaxDynamicSharedMemorySize, LDS_BYTES) != hipSuccess) { fprintf(stderr, "kernel_launch: hipFuncSetAttribute failed\n"); grid = -1; return; }
        hipOccupancyMaxActiveBlocksPerMultiprocessor(&per_cu, (const void*)mega_fwd, 512, LDS_BYTES);
        (void)hipGetLastError();
        if (per_cu < 1) { fprintf(stderr, "kernel_launch: occupancy query says %d blocks per CU\n", per_cu); }
        grid = cus;
    }
    if (grid < 0) return;
    hipMemsetAsync((char*)d_ws + WS_BAR, 0, 16384, stream);
    Params p{};
    p.x_prompt = (const float*)d_in[0]; p.x_sample = (const float*)d_in[1]; p.c = (const float*)d_in[2]; p.state_hgrn = (const float*)d_in[3]; p.c_ctx = (const float*)d_in[4];
    p.w_ada = (const float*)d_in[5]; p.b_ada = (const float*)d_in[6]; p.g_pre = (const float*)d_in[7]; p.g_post = (const float*)d_in[8]; p.w_in_ab = (const float*)d_in[9];
    p.w_out_ab = (const float*)d_in[10]; p.lb_logits = (const float*)d_in[11]; p.g_onorm = (const float*)d_in[12]; p.w_pool = (const float*)d_in[13]; p.pool_scale = (const float*)d_in[14];
    p.w_in_c = (const float*)d_in[15]; p.w_out_c = (const float*)d_in[16]; p.ln_g = (const float*)d_in[17]; p.ln_b = (const float*)d_in[18]; p.w_sp = (const float*)d_in[19]; p.b_sp = (const float*)d_in[20];
    p.out = (float*)d_out; p.ws = (unsigned char*)d_ws;
    void* args[] = {&p};
    hipError_t e = hipLaunchCooperativeKernel((const void*)mega_fwd, dim3(grid), dim3(512), args, LDS_BYTES, stream);
    if (e != hipSuccess) fprintf(stderr, "kernel_launch: cooperative launch failed: %s (grid %d)\n", hipGetErrorString(e), grid);
}
```
